# Optimizing an MI355X kernel written in HIP

```python
import math
import jax, jax.numpy as jnp
from jax import lax
import numpy as np

D_MODEL = 2048
BATCH = 1
SEQ = 8192
DEPTH = 1

N_META = 16
ATTN_WIDTH = D_MODEL // 2
CONV_WIDTH = D_MODEL - ATTN_WIDTH
HEAD_DIM = 128
N_ATTN_HEADS = ATTN_WIDTH // HEAD_DIM
CONV_K = 3
D_FF = -(-(8 * D_MODEL) // (3 * 256)) * 256
Q_BLOCK = 128
IN_COLS = 3 * ATTN_WIDTH + 3 * CONV_WIDTH
EPS = 1e-6

kernel_name = "hymba_stickbreak_shortconv_swiglu"


def _rmsnorm(x, g):
    xf = x.astype(jnp.float32)
    y = xf * lax.rsqrt(jnp.mean(xf * xf, axis=-1, keepdims=True) + EPS)
    return (y * g.astype(jnp.float32)).astype(x.dtype)


def _stick_breaking_block(q_blk, k_ctx, v_ctx, q_start):
    nq = q_blk.shape[1]
    nk = k_ctx.shape[1]
    z = jnp.einsum('bqhd,bkhd->bhqk', q_blk.astype(jnp.float32),
                   k_ctx.astype(jnp.float32)) / math.sqrt(HEAD_DIM)
    qpos = q_start + jnp.arange(nq)
    kpos = jnp.arange(nk)
    causal = kpos[None, :] < qpos[:, None]
    log_beta = jax.nn.log_sigmoid(z)
    log_keep = jnp.where(causal, jax.nn.log_sigmoid(-z), 0.0)
    log_pass = lax.cumsum(log_keep, axis=3, reverse=True) - log_keep
    w = jnp.where(causal, jnp.exp(log_beta + log_pass), 0.0)
    o = jnp.einsum('bhqk,bkhd->bqhd', w, v_ctx.astype(jnp.float32))
    return o.astype(q_blk.dtype)


def _stick_breaking_attention(q, k, v):
    bounds = [(0, N_META)] + [(N_META + i * Q_BLOCK, N_META + (i + 1) * Q_BLOCK)
                              for i in range(SEQ // Q_BLOCK)]
    outs = [_stick_breaking_block(q[:, s:e], k[:, :e], v[:, :e], s) for s, e in bounds]
    return jnp.concatenate(outs, axis=1)


def _causal_dwconv(u, w):
    rhs = w[:, None, :].astype(u.dtype)
    return lax.conv_general_dilated(
        u, rhs, window_strides=(1,), padding=[(CONV_K - 1, 0)],
        dimension_numbers=('NWC', 'WIO', 'NWC'), feature_group_count=u.shape[-1])


def setup_inputs(seed: int = 0) -> dict:
    key = jax.random.key(seed)
    ks = jax.random.split(key, 16)
    f32 = jnp.float32

    def gain(k, shape):
        return 1.0 + 0.02 * jax.random.normal(k, shape, f32)

    return {
        "x": jax.random.normal(ks[0], (BATCH, SEQ, D_MODEL), f32),
        "meta_tokens": jax.random.normal(ks[1], (N_META, D_MODEL), f32),
        "g_mix": gain(ks[2], (DEPTH, D_MODEL)),
        "w_in": jax.random.normal(ks[3], (DEPTH, D_MODEL, IN_COLS), f32) * D_MODEL ** -0.5,
        "g_q": gain(ks[4], (DEPTH, HEAD_DIM)),
        "g_k": gain(ks[5], (DEPTH, HEAD_DIM)),
        "conv_w": jax.random.normal(ks[6], (DEPTH, CONV_K, CONV_WIDTH), f32) * CONV_K ** -0.5,
        "g_attn_out": gain(ks[7], (DEPTH, ATTN_WIDTH)),
        "g_conv_out": gain(ks[8], (DEPTH, CONV_WIDTH)),
        "w_out": jax.random.normal(ks[9], (DEPTH, D_MODEL, D_MODEL), f32) * D_MODEL ** -0.5,
        "g_ffn": gain(ks[10], (DEPTH, D_MODEL)),
        "w_gate": jax.random.normal(ks[11], (DEPTH, D_MODEL, D_FF), f32) * D_MODEL ** -0.5,
        "w_up": jax.random.normal(ks[12], (DEPTH, D_MODEL, D_FF), f32) * D_MODEL ** -0.5,
        "w_down": jax.random.normal(ks[13], (DEPTH, D_FF, D_MODEL), f32) * D_FF ** -0.5,
    }


def reference(x, meta_tokens, g_mix, w_in, g_q, g_k, conv_w, g_attn_out, g_conv_out,
              w_out, g_ffn, w_gate, w_up, w_down):
    b = x.shape[0]
    meta = jnp.broadcast_to(meta_tokens.astype(x.dtype)[None], (b, N_META, D_MODEL))
    h = jnp.concatenate([meta, x], axis=1)
    L = h.shape[1]

    for l in range(DEPTH):
        n = _rmsnorm(h, g_mix[l])
        p = n @ w_in[l]
        q, k, v, gb, gc, u = jnp.split(
            p, np.cumsum([ATTN_WIDTH, ATTN_WIDTH, ATTN_WIDTH, CONV_WIDTH, CONV_WIDTH]), axis=-1)

        q = _rmsnorm(q.reshape(b, L, N_ATTN_HEADS, HEAD_DIM), g_q[l])
        k = _rmsnorm(k.reshape(b, L, N_ATTN_HEADS, HEAD_DIM), g_k[l])
        v = v.reshape(b, L, N_ATTN_HEADS, HEAD_DIM)
        o_attn = _stick_breaking_attention(q, k, v).reshape(b, L, ATTN_WIDTH)

        o_conv = gb * _causal_dwconv(gc * u, conv_w[l])

        o = jnp.concatenate([_rmsnorm(o_attn, g_attn_out[l]),
                             _rmsnorm(o_conv, g_conv_out[l])], axis=-1)
        h = h + o @ w_out[l]

        n2 = _rmsnorm(h, g_ffn[l])
        h = h + (jax.nn.silu(n2 @ w_gate[l]) * (n2 @ w_up[l])) @ w_down[l]

    return h[:, N_META:]
```

```cpp
#include <hip/hip_runtime.h>
#include <hip/hip_cooperative_groups.h>
#include <cstdio>
#include <cstdint>
namespace cg = cooperative_groups;
namespace pg8 {
#define PG8_LAS __attribute__((address_space(3)))
typedef unsigned short bf16_t;
typedef short bf16x8 __attribute__((ext_vector_type(8)));
typedef float f32x4 __attribute__((ext_vector_type(4)));
typedef unsigned u32x4 __attribute__((ext_vector_type(4)));
constexpr int BM = 256, BK = 64, HALF = 128, HTB = HALF * BK * 2  , STAGE_BYTES = 8 * HTB, NXCD = 8, WGM = 8;

__host__ __device__ __forceinline__ int lds_byte(int r, int c) { const int st = (r >> 4) * 2 + (c >> 5), rr = r & 15, cc = c & 31, ob = rr * 64 + cc * 2; return st * 1024 + (ob ^ (((ob >> 9) & 1) << 5)); }
__host__ __device__ __forceinline__ void stage_rc(int b, int& R, int& C) { const int st = b / 1024, sb = b % 1024, swz = sb ^ (((sb >> 9) & 1) << 5); R = (st >> 1) * 16 + swz / 64; C = (st & 1) * 32 + (swz % 64) / 2; }
__host__ __device__ __forceinline__ int perm32(int rho) { const int n = rho >> 4, i = rho & 15; return 8 * (i >> 2) + 4 * n + (i & 3); }

struct Unit { int pm, pn; };
struct Gemm { const bf16_t* A; const bf16_t* Bt; int M, N, K; };

struct StaticOrder {
    int nM, nN, nwg, G, c;
    __host__ __device__ void init(int M, int N, int G_, int c_) { nM = M / BM; nN = N / BM; nwg = nM * nN; G = G_; c = c_; }
    __host__ __device__ bool next(int i, Unit& u) const {
        const long L = (long)i * G + c; if (L >= nwg) return false;
        int wgid = (int)L; { const int q = nwg / NXCD, r = nwg % NXCD, xcd = wgid % NXCD, off = wgid / NXCD; wgid = (xcd < r ? xcd * (q + 1) : r * (q + 1) + (xcd - r) * q) + off; }
        const int nig = WGM * nN, gid = wgid / nig, fm = gid * WGM, gsz = (nM - fm) < WGM ? (nM - fm) : WGM;
        u.pm = fm + ((wgid % nig) % gsz); u.pn = (wgid % nig) / gsz; return true;
    }
    __device__ __forceinline__ void a_ready(const Unit&) const {}
    __device__ __forceinline__ void done(const Unit&) const {}
};

__device__ __forceinline__ unsigned cvt_pk_bf16(float lo, float hi) { unsigned r; asm volatile("v_cvt_pk_bf16_f32 %0, %1, %2" : "=v"(r) : "v"(lo), "v"(hi)); return r; }
typedef float f32x2 __attribute__((ext_vector_type(2)));
__device__ __forceinline__ f32x2 gelu_pk(f32x2 v) {
    const f32x2 av = __builtin_elementwise_abs(v), d = av * 0.2316418882f + 1.0f;
    f32x2 t; t.x = __builtin_amdgcn_rcpf(d.x); t.y = __builtin_amdgcn_rcpf(d.y);
    f32x2 q = t * 0.5307027145f + (-0.7265760135f); q = q * t + 0.7107068705f; q = q * t + (-0.142248368f); q = q * t + 0.127414796f; q = q * t;
    const f32x2 s = (v * v) * (-0.72134752044f);
    f32x2 e; e.x = __builtin_amdgcn_exp2f(s.x); e.y = __builtin_amdgcn_exp2f(s.y);
    const f32x2 m = v * (q * e), r = v - m;
    f32x2 o; o.x = v.x < 0.f ? m.x : r.x; o.y = v.y < 0.f ? m.y : r.y; return o;
}

template <int ACT  > struct EpiBf16 {
    static constexpr bool PERM = true, AFTER_DRAIN = false; static constexpr int KSPLIT = 0; static_assert(ACT == 0 || ACT == 1, "EpiBf16: ACT is 0 (none) or 1 (gelu_pk)");
    bf16_t* O; int ldc; const float* bias; int split_cols; size_t split_stride; float scale0;
    __device__ __forceinline__ void operator()(const f32x4 (&acc)[2][2][4][2], const Unit& u, int wr, int wc, int fr, int fq) const {
        const int row0 = u.pm * BM + wr * 64 + fr; int colt = u.pn * BM; bf16_t* base = O;
        float sc = 1.f; if (split_cols) { const int t = colt / split_cols; base += (size_t)t * split_stride; colt -= t * split_cols; if (t == 0) sc = scale0; }
        const int col0 = colt + wc * 32 + 8 * fq, bcol0 = u.pn * BM + wc * 32 + 8 * fq;
        f32x4 bv[2][2];
#pragma unroll
        for (int bj = 0; bj < 2; ++bj)
#pragma unroll
            for (int n = 0; n < 2; ++n) bv[bj][n] = bias ? *(const f32x4*)(bias + bcol0 + bj * HALF + 4 * n) : (f32x4){0.f, 0.f, 0.f, 0.f};
#pragma unroll
        for (int ai = 0; ai < 2; ++ai)
#pragma unroll
            for (int m = 0; m < 4; ++m) { bf16_t* rowp = base + (size_t)(row0 + ai * HALF + m * 16) * ldc + col0;
#pragma unroll
                for (int bj = 0; bj < 2; ++bj) { f32x4 v0 = acc[ai][bj][m][0] + bv[bj][0], v1 = acc[ai][bj][m][1] + bv[bj][1];
                    if (ACT == 1) { f32x2 a = gelu_pk((f32x2){v0[0], v0[1]}), b = gelu_pk((f32x2){v0[2], v0[3]}), c = gelu_pk((f32x2){v1[0], v1[1]}), d = gelu_pk((f32x2){v1[2], v1[3]});
                        v0 = (f32x4){a.x, a.y, b.x, b.y}; v1 = (f32x4){c.x, c.y, d.x, d.y}; }
                    v0 = v0 * sc; v1 = v1 * sc; u32x4 w; w.x = cvt_pk_bf16(v0[0], v0[1]); w.y = cvt_pk_bf16(v0[2], v0[3]); w.z = cvt_pk_bf16(v1[0], v1[1]); w.w = cvt_pk_bf16(v1[2], v1[3]);
                    *(u32x4*)(rowp + bj * HALF) = w; } }
    }
};
typedef unsigned u32x2 __attribute__((ext_vector_type(2)));
struct EpiRes1 {
    static constexpr bool PERM = true, AFTER_DRAIN = false; static constexpr int KSPLIT = 16;
    const bf16_t* xn; const float* irs1; const float* gmix; bf16_t* a2; const float* g; float* ss; int ldc; const float* ssa; float inv_na, eps;
    __device__ __forceinline__ void ksplit(f32x4 (&acc)[2][2][4][2], const Unit& u, int wr, int wc, int fr, int fq) const {
        float rs[2][4];
#pragma unroll
        for (int ai = 0; ai < 2; ++ai)
#pragma unroll
            for (int m = 0; m < 4; ++m) rs[ai][m] = ssa[u.pm * BM + ai * HALF + wr * 64 + m * 16 + fr];
#pragma unroll
        for (int ai = 0; ai < 2; ++ai)
#pragma unroll
            for (int m = 0; m < 4; ++m) { const float r = 1.0f / sqrtf(rs[ai][m] * inv_na + eps);
#pragma unroll
                for (int bj = 0; bj < 2; ++bj)
#pragma unroll
                    for (int n = 0; n < 2; ++n) acc[ai][bj][m][n] *= r; }
    }
    __device__ __forceinline__ void operator()(const f32x4 (&acc)[2][2][4][2], const Unit& u, int wr, int wc, int fr, int fq) const {
        const int col0 = u.pn * BM + wc * 32 + 8 * fq;
        f32x4 gv[2][2], gi[2][2];
#pragma unroll
        for (int bj = 0; bj < 2; ++bj)
#pragma unroll
            for (int n = 0; n < 2; ++n) { gv[bj][n] = *(const f32x4*)(g + col0 + bj * HALF + 4 * n); const f32x4 gm = *(const f32x4*)(gmix + col0 + bj * HALF + 4 * n);
                gi[bj][n] = (f32x4){1.0f / gm[0], 1.0f / gm[1], 1.0f / gm[2], 1.0f / gm[3]}; }
#pragma unroll
        for (int ai = 0; ai < 2; ++ai)
#pragma unroll
            for (int m = 0; m < 4; ++m) { const int row = u.pm * BM + ai * HALF + wr * 64 + m * 16 + fr; const size_t off = (size_t)row * ldc + col0; float s = 0.f; const float ir = irs1[row];
#pragma unroll
                for (int bj = 0; bj < 2; ++bj) { const u32x4 xw = *(const u32x4*)(xn + off + bj * HALF);
                    const f32x4 h0 = (f32x4){__uint_as_float(xw.x << 16), __uint_as_float(xw.x & 0xffff0000u), __uint_as_float(xw.y << 16), __uint_as_float(xw.y & 0xffff0000u)} * gi[bj][0] * ir + acc[ai][bj][m][0];
                    const f32x4 h1 = (f32x4){__uint_as_float(xw.z << 16), __uint_as_float(xw.z & 0xffff0000u), __uint_as_float(xw.w << 16), __uint_as_float(xw.w & 0xffff0000u)} * gi[bj][1] * ir + acc[ai][bj][m][1];
                    s += ((h0[0] * h0[0] + h0[1] * h0[1]) + (h0[2] * h0[2] + h0[3] * h0[3])) + ((h1[0] * h1[0] + h1[1] * h1[1]) + (h1[2] * h1[2] + h1[3] * h1[3]));
                    const f32x4 a0 = h0 * gv[bj][0], a1 = h1 * gv[bj][1];
                    u32x4 w; w.x = cvt_pk_bf16(a0[0], a0[1]); w.y = cvt_pk_bf16(a0[2], a0[3]); w.z = cvt_pk_bf16(a1[0], a1[1]); w.w = cvt_pk_bf16(a1[2], a1[3]);
                    *(u32x4*)(a2 + off + bj * HALF) = w; }
                s += __shfl_xor(s, 16); s += __shfl_xor(s, 32);
                if (fq == 0) atomicAdd(ss + row, s);
                if (m & 1) asm volatile("" ::: "memory"); }
    }
};
struct EpiSwiGLU {
    static constexpr bool PERM = true, AFTER_DRAIN = false; static constexpr int KSPLIT = 0;
    bf16_t* O; int ldc; const float* ss; float inv_n, eps;
    __device__ __forceinline__ void operator()(const f32x4 (&acc)[2][2][4][2], const Unit& u, int wr, int wc, int fr, int fq) const {
        const int col0 = u.pn * HALF + wc * 32 + 8 * fq;
#pragma unroll
        for (int ai = 0; ai < 2; ++ai)
#pragma unroll
            for (int m = 0; m < 4; ++m) { const int row = u.pm * BM + ai * HALF + wr * 64 + m * 16 + fr; const float r = __builtin_amdgcn_rsqf(ss[row] * inv_n + eps);
                float hv[8];
#pragma unroll
                for (int n = 0; n < 2; ++n)
#pragma unroll
                    for (int i = 0; i < 4; ++i) { const float gt = acc[ai][0][m][n][i] * r, up = acc[ai][1][m][n][i] * r;
                        const float sg = gt * __builtin_amdgcn_rcpf(1.0f + __builtin_amdgcn_exp2f(-1.4426950408889634f * gt)); hv[n * 4 + i] = sg * up; }
                u32x4 w; w.x = cvt_pk_bf16(hv[0], hv[1]); w.y = cvt_pk_bf16(hv[2], hv[3]); w.z = cvt_pk_bf16(hv[4], hv[5]); w.w = cvt_pk_bf16(hv[6], hv[7]);
                *(u32x4*)(O + (size_t)row * ldc + col0) = w; }
    }
};
struct EpiRes2 {
    static constexpr bool PERM = true, AFTER_DRAIN = false; static constexpr int KSPLIT = 0;
    const bf16_t* a2; const float* g; float* out; int ldc;
    __device__ __forceinline__ void operator()(const f32x4 (&acc)[2][2][4][2], const Unit& u, int wr, int wc, int fr, int fq) const {
        const int col0 = u.pn * BM + wc * 32 + 8 * fq;
        f32x4 gi[2][2];
#pragma unroll
        for (int bj = 0; bj < 2; ++bj)
#pragma unroll
            for (int n = 0; n < 2; ++n) { const f32x4 gv = *(const f32x4*)(g + col0 + bj * HALF + 4 * n); gi[bj][n] = (f32x4){1.0f / gv[0], 1.0f / gv[1], 1.0f / gv[2], 1.0f / gv[3]}; }
#pragma unroll
        for (int ai = 0; ai < 2; ++ai)
#pragma unroll
            for (int m = 0; m < 4; ++m) { const int row = u.pm * BM + ai * HALF + wr * 64 + m * 16 + fr; const size_t off = (size_t)row * ldc + col0;
#pragma unroll
                for (int bj = 0; bj < 2; ++bj) { const u32x4 w = *(const u32x4*)(a2 + off + bj * HALF);
                    const f32x4 h0 = (f32x4){__uint_as_float(w.x << 16), __uint_as_float(w.x & 0xffff0000u), __uint_as_float(w.y << 16), __uint_as_float(w.y & 0xffff0000u)} * gi[bj][0];
                    const f32x4 h1 = (f32x4){__uint_as_float(w.z << 16), __uint_as_float(w.z & 0xffff0000u), __uint_as_float(w.w << 16), __uint_as_float(w.w & 0xffff0000u)} * gi[bj][1];
                    *(f32x4*)(out + off + bj * HALF) = h0 + acc[ai][bj][m][0]; *(f32x4*)(out + off + bj * HALF + 4) = h1 + acc[ai][bj][m][1]; }
                if (m & 1) asm volatile("" ::: "memory"); }
    }
};
struct EpiIn {
    static constexpr bool PERM = true, AFTER_DRAIN = false; static constexpr int KSPLIT = 0;
    bf16_t* O; int ldc;
    __device__ __forceinline__ void operator()(const f32x4 (&acc)[2][2][4][2], const Unit& u, int wr, int wc, int fr, int fq) const {
        const int row0 = u.pm * BM + wr * 64 + fr;
        if (u.pn < 16) {
            const int col0 = u.pn * BM + wc * 32 + 8 * fq;
#pragma unroll
            for (int ai = 0; ai < 2; ++ai)
#pragma unroll
                for (int m = 0; m < 4; ++m) { bf16_t* rowp = O + (size_t)(row0 + ai * HALF + m * 16) * ldc + col0;
#pragma unroll
                    for (int bj = 0; bj < 2; ++bj) { const f32x4 v0 = acc[ai][bj][m][0], v1 = acc[ai][bj][m][1];
                        u32x4 w; w.x = cvt_pk_bf16(v0[0], v0[1]); w.y = cvt_pk_bf16(v0[2], v0[3]); w.z = cvt_pk_bf16(v1[0], v1[1]); w.w = cvt_pk_bf16(v1[2], v1[3]);
                        *(u32x4*)(rowp + bj * HALF) = w; } }
        } else {
            const int col0 = 4096 + (u.pn - 16) * HALF + wc * 32 + 8 * fq;
#pragma unroll
            for (int ai = 0; ai < 2; ++ai)
#pragma unroll
                for (int m = 0; m < 4; ++m) { const f32x4 v0 = acc[ai][0][m][0] * acc[ai][1][m][0], v1 = acc[ai][0][m][1] * acc[ai][1][m][1];
                    u32x4 w; w.x = cvt_pk_bf16(v0[0], v0[1]); w.y = cvt_pk_bf16(v0[2], v0[3]); w.z = cvt_pk_bf16(v1[0], v1[1]); w.w = cvt_pk_bf16(v1[2], v1[3]);
                    *(u32x4*)(O + (size_t)(row0 + ai * HALF + m * 16) * ldc + col0) = w; }
        }
    }
};
template <class Epi, class Sched, bool ALIGN_EPI = false, bool SP2 = false>
__device__ __forceinline__ void gemm_phase(PG8_LAS unsigned char* lds, const Gemm g, const Sched& S, const Epi& E) {
    int tid_ = threadIdx.x; asm volatile("" : "+v"(tid_));
    const int tid = tid_, wid = __builtin_amdgcn_readfirstlane(tid >> 6), lane = tid & 63, wr = wid >> 2, wc = wid & 3, fr = lane & 15, fq = lane >> 4;
    const int K = g.K, nt = K / BK;
    unsigned voffA[2], voffB[2];
#pragma unroll
    for (int i = 0; i < 2; ++i) { int R, C; stage_rc(tid * 16 + i * 8192, R, C); const int Rb = Epi::PERM ? ((R & ~31) + perm32(R & 31)) : R;
        voffA[i] = (unsigned)(R * K + C) * 2u; voffB[i] = (unsigned)(Rb * K + C) * 2u; }
    const size_t kstep = (size_t)(BK * 2);
    const size_t hstep = (size_t)HALF * K * 2;
    const size_t tstep = 2 * hstep;
    const unsigned ldsw = (unsigned)wid * 1024u;
    const int aoff = lds_byte(wr * 64 + fr, fq * 8), boff = lds_byte(wc * 32 + fr, fq * 8);
#define PG8_SA(b, h) (((b) * 2 + (h)) * HTB)
#define PG8_SB(b, h) ((4 + (b) * 2 + (h)) * HTB)
#define PG8_STAGE(bufoff, gbase, voff) do { _Pragma("unroll") for (int _i = 0; _i < 2; ++_i) \
        __builtin_amdgcn_global_load_lds((const unsigned*)((const char*)(gbase) + (voff)[_i]), (PG8_LAS unsigned*)(lds + (bufoff) + ldsw + _i * 8192), 16, 0, 0); } while (0)
#define PG8_LDA(dst, b, h) do { _Pragma("unroll") for (int m = 0; m < 4; ++m) _Pragma("unroll") for (int k = 0; k < 2; ++k) dst[m][k] = *(const PG8_LAS bf16x8*)(lds + PG8_SA(b, h) + aoff + m * 2048 + k * 1024); } while (0)
#define PG8_LDB(dst, b, h) do { _Pragma("unroll") for (int n = 0; n < 2; ++n) _Pragma("unroll") for (int k = 0; k < 2; ++k) dst[n][k] = *(const PG8_LAS bf16x8*)(lds + PG8_SB(b, h) + boff + n * 2048 + k * 1024); } while (0)
#define PG8_MMA(ai, bj, At, Bt) do { __builtin_amdgcn_s_setprio(1); _Pragma("unroll") for (int m = 0; m < 4; ++m) _Pragma("unroll") for (int n = 0; n < 2; ++n) _Pragma("unroll") for (int k = 0; k < 2; ++k) \
        acc[ai][bj][m][n] = __builtin_amdgcn_mfma_f32_16x16x32_bf16(Bt[n][k], At[m][k], acc[ai][bj][m][n], 0, 0, 0); __builtin_amdgcn_s_setprio(0); } while (0)
#define PG8_WAIT_V(n) asm volatile("s_waitcnt vmcnt(" #n ")" ::: "memory")
#define PG8_WAIT_L(n) asm volatile("s_waitcnt lgkmcnt(" #n ")" ::: "memory")
#define PG8_BAR __builtin_amdgcn_s_barrier()
#define PG8_SCHED __builtin_amdgcn_sched_barrier(0)
    Unit cur, nxt; int ui = 0;
    if (!S.next(0, cur)) return;
    f32x4 acc[2][2][4][2];
#pragma unroll
    for (int a = 0; a < 2; ++a)
#pragma unroll
        for (int b = 0; b < 2; ++b)
#pragma unroll
            for (int m = 0; m < 4; ++m)
#pragma unroll
                for (int n = 0; n < 2; ++n) acc[a][b][m][n] = (f32x4){0.f, 0.f, 0.f, 0.f};
    bf16x8 At[4][2], B0[2][2], B1[2][2];
    const char* cA = (const char*)g.A + (size_t)cur.pm * tstep; const char* cB = (const char*)g.Bt + (size_t)cur.pn * tstep;
    S.a_ready(cur);
    if constexpr (SP2) {
        PG8_STAGE(PG8_SB(0, 0), cB, voffB); PG8_STAGE(PG8_SB(0, 1), cB + hstep, voffB); PG8_STAGE(PG8_SA(0, 0), cA, voffA); PG8_STAGE(PG8_SA(0, 1), cA + hstep, voffA);
        if (wr == 1) PG8_BAR;
        PG8_WAIT_V(2); PG8_BAR;
        PG8_STAGE(PG8_SB(1, 0), cB + kstep, voffB); PG8_STAGE(PG8_SA(1, 0), cA + kstep, voffA); PG8_STAGE(PG8_SB(1, 1), cB + hstep + kstep, voffB);
        PG8_WAIT_V(6); PG8_BAR;
    } else {
        PG8_STAGE(PG8_SB(0, 0), cB, voffB); PG8_STAGE(PG8_SA(0, 0), cA, voffA); PG8_STAGE(PG8_SB(0, 1), cB + hstep, voffB); PG8_STAGE(PG8_SA(0, 1), cA + hstep, voffA);
        if (wr == 1) PG8_BAR;
        PG8_WAIT_V(4); PG8_BAR;
        PG8_STAGE(PG8_SB(1, 0), cB + kstep, voffB); PG8_STAGE(PG8_SA(1, 0), cA + kstep, voffA); PG8_STAGE(PG8_SB(1, 1), cB + hstep + kstep, voffB);
        PG8_WAIT_V(6); PG8_BAR;
    }
    for (;;) {
        const bool has_next = S.next(ui + 1, nxt);
        const char* nA = has_next ? (const char*)g.A + (size_t)nxt.pm * tstep : cA; const char* nB = has_next ? (const char*)g.Bt + (size_t)nxt.pn * tstep : cB;
        for (int t = 0; t < nt; t += 2) {
            const bool last = (t == nt - 2);
            const char* a1 = cA + (size_t)(t + 1) * kstep;
            const char* a2 = last ? nA : cA + (size_t)(t + 2) * kstep; const char* b2 = last ? nB : cB + (size_t)(t + 2) * kstep;
            const char* a3 = a2 + kstep; const char* b3 = b2 + kstep;
            if (last && has_next) S.a_ready(nxt);
            if constexpr (Epi::KSPLIT > 0) { if (t == Epi::KSPLIT) E.ksplit(acc, cur, wr, wc, fr, fq); }
            if constexpr (SP2) {
            PG8_LDB(B0, 0, 0); PG8_LDB(B1, 0, 1); PG8_SCHED; PG8_LDA(At, 0, 0); PG8_STAGE(PG8_SA(1, 1), a1 + hstep, voffA);
            PG8_WAIT_V(8); PG8_WAIT_L(0); PG8_BAR; PG8_MMA(0, 0, At, B0); PG8_MMA(0, 1, At, B1); PG8_BAR; PG8_SCHED;
            PG8_LDA(At, 0, 1); PG8_STAGE(PG8_SB(0, 0), b2, voffB); PG8_STAGE(PG8_SB(0, 1), b2 + hstep, voffB); PG8_STAGE(PG8_SA(0, 0), a2, voffA);
            PG8_WAIT_V(8); PG8_WAIT_L(0); PG8_BAR; PG8_MMA(1, 0, At, B0); PG8_MMA(1, 1, At, B1); PG8_BAR; PG8_SCHED;
            PG8_LDB(B0, 1, 0); PG8_LDB(B1, 1, 1); PG8_SCHED; PG8_LDA(At, 1, 0); PG8_STAGE(PG8_SA(0, 1), a2 + hstep, voffA);
            PG8_WAIT_V(8); PG8_WAIT_L(0); PG8_BAR; PG8_MMA(0, 0, At, B0); PG8_MMA(0, 1, At, B1); PG8_BAR; PG8_SCHED;
            PG8_LDA(At, 1, 1); PG8_STAGE(PG8_SB(1, 0), b3, voffB); PG8_STAGE(PG8_SB(1, 1), b3 + hstep, voffB); PG8_STAGE(PG8_SA(1, 0), a3, voffA);
            PG8_WAIT_V(8); PG8_WAIT_L(0); PG8_BAR; PG8_MMA(1, 0, At, B0); PG8_MMA(1, 1, At, B1); PG8_BAR; PG8_SCHED;
            } else {
            PG8_LDB(B0, 0, 0); PG8_SCHED; PG8_LDA(At, 0, 0); PG8_STAGE(PG8_SA(1, 1), a1 + hstep, voffA);
            PG8_WAIT_L(8); PG8_BAR; PG8_WAIT_L(0); PG8_MMA(0, 0, At, B0); PG8_BAR; PG8_SCHED;
            PG8_LDB(B1, 0, 1); PG8_STAGE(PG8_SB(0, 0), b2, voffB);
            PG8_BAR; PG8_WAIT_L(0); PG8_MMA(0, 1, At, B1); PG8_BAR;
            PG8_LDA(At, 0, 1); PG8_STAGE(PG8_SA(0, 0), a2, voffA);
            PG8_BAR; PG8_WAIT_L(0); PG8_MMA(1, 0, At, B0); PG8_BAR; PG8_SCHED;
            PG8_STAGE(PG8_SB(0, 1), b2 + hstep, voffB);
            PG8_WAIT_V(6); PG8_BAR; PG8_MMA(1, 1, At, B1); PG8_BAR;
            PG8_LDB(B0, 1, 0); PG8_SCHED; PG8_LDA(At, 1, 0); PG8_STAGE(PG8_SA(0, 1), a2 + hstep, voffA);
            PG8_WAIT_L(8); PG8_BAR; PG8_WAIT_L(0); PG8_MMA(0, 0, At, B0); PG8_BAR; PG8_SCHED;
            PG8_LDB(B1, 1, 1); PG8_STAGE(PG8_SB(1, 0), b3, voffB);
            PG8_BAR; PG8_WAIT_L(0); PG8_MMA(0, 1, At, B1); PG8_BAR;
            PG8_LDA(At, 1, 1); PG8_STAGE(PG8_SA(1, 0), a3, voffA);
            PG8_BAR; PG8_WAIT_L(0); PG8_MMA(1, 0, At, B0); PG8_BAR; PG8_SCHED;
            PG8_STAGE(PG8_SB(1, 1), b3 + hstep, voffB);
            PG8_WAIT_V(6); PG8_BAR; PG8_MMA(1, 1, At, B1); PG8_BAR;
            }
        }
        if constexpr (ALIGN_EPI) { if (wr == 0) PG8_BAR; }
        if constexpr (!Epi::AFTER_DRAIN) { E(acc, cur, wr, wc, fr, fq); S.done(cur); }
        if (!has_next) break;
#pragma unroll
        for (int a = 0; a < 2; ++a)
#pragma unroll
            for (int b = 0; b < 2; ++b)
#pragma unroll
                for (int m = 0; m < 4; ++m)
#pragma unroll
                    for (int n = 0; n < 2; ++n) acc[a][b][m][n] = (f32x4){0.f, 0.f, 0.f, 0.f};
        cur = nxt; cA = nA; cB = nB; ++ui;
        if constexpr (ALIGN_EPI) { if (wr == 1) PG8_BAR; }
    }
    PG8_WAIT_V(0);
    if constexpr (!ALIGN_EPI) { if (wr == 0) PG8_BAR; }
    PG8_BAR;
    if constexpr (Epi::AFTER_DRAIN) { E.fused(acc, cur, wr, wc, fr, fq, lds, wid, lane); S.done(cur); }
#undef PG8_SA
#undef PG8_SB
#undef PG8_STAGE
#undef PG8_LDA
#undef PG8_LDB
#undef PG8_MMA
#undef PG8_WAIT_V
#undef PG8_WAIT_L
#undef PG8_BAR
#undef PG8_SCHED
}
}
#ifndef PG8_SP2
#define PG8_SP2 true
#endif
#ifndef PG8_ALIGN
#define PG8_ALIGN true
#endif
constexpr int SEQ = 8192, DM = 2048, NMETA = 16, AW = 1024, CWID = 1024, HD = 128, NH = 8, DFF = 5632, INC = 6144;
constexpr float EPS = 1e-6f;
constexpr int NWAVES = 8;
constexpr size_t MiB = 1u << 20;
constexpr size_t WS_SS2 = 0, WS_SSA = 32 * 1024, WS_XNMETA = 64 * 1024, WS_PMETA = 128 * 1024, WS_BAR = 320 * 1024, WS_IRS1 = 384 * 1024;
constexpr size_t WS_WOUT = 1 * MiB, WS_WGU = 9 * MiB, WS_WD = 53 * MiB, WS_WIN = 75 * MiB  , WS_P = 107 * MiB  , WS_OC = 204 * MiB, WS_END = 236 * MiB;
constexpr size_t OUT_XN = 0, OUT_OA = 32 * MiB;
constexpr int LDS_BYTES = 147456;

#define LAS __attribute__((address_space(3)))
typedef unsigned short bf16;
typedef unsigned v4u __attribute__((ext_vector_type(4)));
typedef unsigned v2u __attribute__((ext_vector_type(2)));
typedef float f32x4 __attribute__((ext_vector_type(4)));
typedef float f32x16 __attribute__((ext_vector_type(16)));
typedef short bf16x8 __attribute__((ext_vector_type(8)));
#define LDS_WAIT() asm volatile("s_waitcnt lgkmcnt(0)" ::: "memory")
__device__ __forceinline__ unsigned pk2(float lo, float hi) { return pg8::cvt_pk_bf16(lo, hi); }
__device__ __forceinline__ float bflo(unsigned u) { return __uint_as_float(u << 16); }
__device__ __forceinline__ float bfhi(unsigned u) { return __uint_as_float(u & 0xffff0000u); }
template <int CTRL, int ROWMASK> __device__ __forceinline__ float dpp_f(float old, float src) {
    return __builtin_bit_cast(float, __builtin_amdgcn_update_dpp(__builtin_bit_cast(int, old), __builtin_bit_cast(int, src), CTRL, ROWMASK, 0xF, false)); }
__device__ __forceinline__ float row16_sum(float v) {
    v += dpp_f<0xB1, 0xF>(0.f, v);
    v += dpp_f<0x4E, 0xF>(0.f, v);
    v += dpp_f<0x141, 0xF>(0.f, v);
    v += dpp_f<0x140, 0xF>(0.f, v);
    return v;
}
__device__ __forceinline__ float half32_sum_hi(float v) { v = row16_sum(v); v += dpp_f<0x142, 0xA>(0.f, v); return v; }
__device__ __forceinline__ float wave_sum(float v) {
    v = row16_sum(v); v += dpp_f<0x142, 0xA>(0.f, v); v += dpp_f<0x143, 0xC>(0.f, v);
    return __builtin_bit_cast(float, __builtin_amdgcn_readlane(__builtin_bit_cast(int, v), 63));
}
__device__ __forceinline__ int crow(int r, int hi) { return (r & 3) + 8 * (r >> 2) + 4 * hi; }

__device__ __forceinline__ void p0_transpose_item(const float* __restrict__ W, int N, bf16* __restrict__ WT, int K, int k0, int n0, int drow0, LAS unsigned char* scr, int lane) {
    const int l15 = lane & 15, q = lane >> 4;
    f32x4 v[16];
    const float* src = W + (size_t)(k0 + 2 * q) * N + n0 + 4 * l15;
#pragma unroll
    for (int i = 0; i < 16; ++i) v[i] = __builtin_nontemporal_load((const f32x4*)(src + (size_t)((i & 1) + 8 * (i >> 1)) * N));
#pragma unroll
    for (int j = 0; j < 8; ++j)
#pragma unroll
        for (int c = 0; c < 4; ++c) { const int n = 4 * l15 + c;
            *(LAS unsigned*)(scr + n * 128 + ((j ^ (l15 & 7)) * 16) + 4 * q) = pk2(v[2 * j][c], v[2 * j + 1][c]); }
    LDS_WAIT(); asm volatile("" ::: "memory");
    const int kc = lane & 7;
#pragma unroll
    for (int r = 0; r < 8; ++r) { const int n = (lane >> 3) + 8 * r; const v4u o = *(const LAS v4u*)(scr + n * 128 + ((kc ^ ((n >> 2) & 7)) * 16));
        *(v4u*)(WT + (size_t)(drow0 + n) * K + k0 + 8 * kc) = o; }
    LDS_WAIT(); asm volatile("" ::: "memory");
}
__device__ __forceinline__ void rms_row_to_bf16(const float* __restrict__ xrow, const float* __restrict__ g, bf16* __restrict__ orow, float* __restrict__ inv_rstd_out, int lane) {
    const f32x4* xr = (const f32x4*)xrow + 2 * lane; const f32x4* gr = (const f32x4*)g + 2 * lane;
    f32x4 v[8]; float s = 0.f;
#pragma unroll
    for (int j = 0; j < 4; ++j) { v[2 * j] = __builtin_nontemporal_load(xr + 128 * j); v[2 * j + 1] = __builtin_nontemporal_load(xr + 128 * j + 1); }
#pragma unroll
    for (int j = 0; j < 8; ++j) s += (v[j][0] * v[j][0] + v[j][1] * v[j][1]) + (v[j][2] * v[j][2] + v[j][3] * v[j][3]);
    const float var = wave_sum(s) * (1.0f / DM) + EPS; const float rstd = 1.0f / sqrtf(var);
    if (inv_rstd_out && lane == 0) *inv_rstd_out = sqrtf(var);
    v4u* o16 = (v4u*)orow + lane;
#pragma unroll
    for (int j = 0; j < 4; ++j) { const f32x4 ga = gr[128 * j], gb = gr[128 * j + 1]; const f32x4 a = v[2 * j], b = v[2 * j + 1]; v4u w;
        w.x = pk2(a[0] * rstd * ga[0], a[1] * rstd * ga[1]); w.y = pk2(a[2] * rstd * ga[2], a[3] * rstd * ga[3]);
        w.z = pk2(b[0] * rstd * gb[0], b[1] * rstd * gb[1]); w.w = pk2(b[2] * rstd * gb[2], b[3] * rstd * gb[3]); o16[64 * j] = w; }
}

struct Args { const float* in[14]; float* out; unsigned char* ws; };

__device__ __forceinline__ void p0_prologue(const Args& A, LAS unsigned char* lds, int gw, int NGW, int wave, int lane) {
    const float* x = A.in[0]; const float* meta = A.in[1]; const float* g_mix = A.in[2]; const float* w_in = A.in[3];
    const float* w_out = A.in[9]; const float* w_gate = A.in[11]; const float* w_up = A.in[12]; const float* w_down = A.in[13];
    unsigned char* ws = A.ws;
    bf16* WinT = (bf16*)(ws + WS_WIN); bf16* WoutT = (bf16*)(ws + WS_WOUT); bf16* WguT = (bf16*)(ws + WS_WGU); bf16* WdT = (bf16*)(ws + WS_WD);
    bf16* XN = (bf16*)((unsigned char*)A.out + OUT_XN); bf16* XNmeta = (bf16*)(ws + WS_XNMETA); float* ss2 = (float*)(ws + WS_SS2); float* irs1 = (float*)(ws + WS_IRS1);
    LAS unsigned char* scr = lds + wave * 8192;
    constexpr int I_IN = (DM / 64) * (INC / 64), I_OUT = (DM / 64) * (DM / 64), I_G = (DM / 64) * (DFF / 64);
    constexpr int NITEMS = I_IN + I_OUT + 2 * I_G;
    for (int it = gw; it < NITEMS; it += NGW) {
        int r = it;
        if (r < I_IN) { const int nb = INC / 64, kb = r / nb, n0 = 64 * (r % nb);
            const int ch0 = (n0 - 4096) & 1023, drow0 = n0 < 4096 ? n0 : 4096 + (ch0 >> 7) * 256 + (n0 >= 5120 ? 128 : 0) + (ch0 & 127);
            p0_transpose_item(w_in, INC, WinT, DM, 64 * kb, n0, drow0, scr, lane); continue; } r -= I_IN;
        if (r < I_OUT) { const int nb = DM / 64, kb = r / nb, n0 = 64 * (r % nb); p0_transpose_item(w_out, DM, WoutT, DM, 64 * kb, n0, n0, scr, lane); continue; } r -= I_OUT;
        if (r < I_G) { const int nb = DFF / 64, kb = r / nb, n0 = 64 * (r % nb); p0_transpose_item(w_gate, DFF, WguT, DM, 64 * kb, n0, (n0 >> 7) * 256 + (n0 & 127), scr, lane); continue; } r -= I_G;
        { const int nb = DFF / 64, kb = r / nb, n0 = 64 * (r % nb); p0_transpose_item(w_up, DFF, WguT, DM, 64 * kb, n0, (n0 >> 7) * 256 + 128 + (n0 & 127), scr, lane); }
    }
    for (int m = gw; m < SEQ; m += NGW) rms_row_to_bf16(x + (size_t)m * DM, g_mix, XN + (size_t)m * DM, irs1 + m, lane);
    { const int mr = NGW - 1 - gw;
      if (mr < NMETA) rms_row_to_bf16(meta + (size_t)mr * DM, g_mix, XNmeta + (size_t)mr * DM, nullptr, lane); }
    for (int i = gw * 64 + lane; i < 2 * SEQ; i += NGW * 64) ss2[i] = 0.f;
}

__device__ __forceinline__ void wd_convert(const float* __restrict__ w_down, bf16* __restrict__ WdT, LAS unsigned char* lds, int w, int nw, int wave, int lane) {
    LAS unsigned char* scr = lds + wave * 8192;
    constexpr int I_D = (DFF / 64) * (DM / 64);
    for (int r = w; r < I_D; r += nw) { const int nb = DM / 64, kb = r / nb, n0 = 64 * (r % nb); p0_transpose_item(w_down, DM, WdT, DFF, 64 * kb, n0, n0, scr, lane); }
}
__device__ __forceinline__ void p1_meta(const bf16* __restrict__ XNmeta, const bf16* __restrict__ WinT, bf16* __restrict__ Pmeta, LAS unsigned char* lds, int b, int wave, int lane) {
    LAS f32x4* red = (LAS f32x4*)lds;
    const int tile = 2 * b + (wave >> 2), kq = wave & 3;
    f32x4 acc = {0.f, 0.f, 0.f, 0.f};
    {
        const bf16* arow = XNmeta + (size_t)(lane & 15) * DM + 8 * (lane >> 4) + 512 * kq;
        const bf16* brow = WinT + (size_t)(16 * tile + (lane & 15)) * DM + 8 * (lane >> 4) + 512 * kq;
#pragma unroll
        for (int s = 0; s < 16; ++s) { const bf16x8 a = *(const bf16x8*)(arow + 32 * s); const bf16x8 w = *(const bf16x8*)(brow + 32 * s);
            acc = __builtin_amdgcn_mfma_f32_16x16x32_bf16(w, a, acc, 0, 0, 0); }
    }
    red[wave * 64 + lane] = acc;
    __syncthreads();
    if (kq == 0) {
        f32x4 s = red[wave * 64 + lane] + red[(wave + 1) * 64 + lane] + red[(wave + 2) * 64 + lane] + red[(wave + 3) * 64 + lane];
        v2u w; w.x = pk2(s[0], s[1]); w.y = pk2(s[2], s[3]);
        *(v2u*)(Pmeta + (size_t)(lane & 15) * INC + 16 * tile + 4 * (lane >> 4)) = w;
    }
    __syncthreads();
}
#define XB_TMO      128
#define XB_XCNT(j)  (256  + 64 * (j))
#define XB_XSUB(j)  (1280 + 64 * (j))
#define XB_XGEN(j)  (2304 + 64 * (j))
#define XB_TOP      3328
#define XB_TOPGEN   3392
#define XCD_BAR_WORDS 3456
#define XB_SPIN_CAP (1u << 18)

__device__ __forceinline__ unsigned xb_ld(unsigned* p)              { return __hip_atomic_load(p, __ATOMIC_RELAXED, __HIP_MEMORY_SCOPE_AGENT); }
__device__ __forceinline__ unsigned xb_add(unsigned* p, unsigned v) { return __hip_atomic_fetch_add(p, v, __ATOMIC_RELAXED, __HIP_MEMORY_SCOPE_AGENT); }
__device__ __forceinline__ unsigned xb_xcc_id() { return (unsigned)__builtin_amdgcn_s_getreg((3 << 11) | 20) & 0xFu; }
#define XB_SPIN(cond, bar) do { unsigned _sp = 0; while (cond) { __builtin_amdgcn_s_sleep(1); \
    if ((++_sp & 255u) == 0u) { if (xb_ld(&(bar)[XB_TMO])) break; if (_sp > XB_SPIN_CAP) { atomicAdd(&(bar)[XB_TMO], 1u); break; } } } } while (0)

struct XcdBarrier {
    unsigned* bar; unsigned x;
    volatile LAS unsigned* st;
};

__device__ __forceinline__ XcdBarrier xcd_barrier_post(unsigned* bar, volatile LAS unsigned* st) {
    XcdBarrier b; b.bar = bar; b.x = xb_xcc_id(); b.st = st;
    if (threadIdx.x == 0) (void)xb_add(&bar[XB_XCNT(b.x)], 1u);
    return b;
}
__device__ __forceinline__ void xcd_barrier_complete(unsigned* bar, unsigned x, unsigned& nloc, unsigned& nx) {
    const unsigned G = gridDim.x * gridDim.y * gridDim.z;
    unsigned sum, cnt, mine, sp = 0u;
    for (;;) {
        sum = 0u; cnt = 0u; mine = 0u;
#pragma unroll
        for (unsigned j = 0; j < 16; ++j) { const unsigned c = xb_ld(&bar[XB_XCNT(j)]); sum += c; cnt += (c > 0u) ? 1u : 0u; mine = (j == x) ? c : mine; }
        if (sum == G) break;
        __builtin_amdgcn_s_sleep(1);
        if ((++sp & 255u) == 0u) { if (xb_ld(&bar[XB_TMO])) break; if (sp > XB_SPIN_CAP) { atomicAdd(&bar[XB_TMO], 1u); break; } }
    }
    nloc = mine > 0u ? mine : 1u; nx = cnt > 0u ? cnt : 1u;
}

__device__ __forceinline__ void xcd_barrier(const XcdBarrier& b) {
    asm volatile("s_waitcnt vmcnt(0)" ::: "memory");
    __syncthreads();
    if (threadIdx.x == 0) {
        unsigned* bar = b.bar;
        __builtin_amdgcn_s_waitcnt(0);
        unsigned nloc = b.st[0], nx = b.st[1];
        if (nloc == 0u) { xcd_barrier_complete(bar, b.x, nloc, nx); b.st[0] = nloc; b.st[1] = nx; }
        const unsigned old = xb_add(&bar[XB_XSUB(b.x)], 1u);
        const unsigned gen = old / nloc;
        if (old + 1u == (gen + 1u) * nloc) {
            __builtin_amdgcn_fence(__ATOMIC_RELEASE, "agent");
            asm volatile("s_waitcnt vmcnt(0)" ::: "memory");
            const unsigned og = xb_add(&bar[XB_TOP], 1u);
            const unsigned tg = og / nx;
            if (og + 1u == (tg + 1u) * nx) xb_add(&bar[XB_TOPGEN], 1u);
            else XB_SPIN(xb_ld(&bar[XB_TOPGEN]) == tg, bar);
            __builtin_amdgcn_fence(__ATOMIC_ACQUIRE, "agent");
            xb_add(&bar[XB_XGEN(b.x)], 1u);
            asm volatile("s_waitcnt vmcnt(0)" ::: "memory");
        } else {
            XB_SPIN(xb_ld(&bar[XB_XGEN(b.x)]) == gen, bar);
            __builtin_amdgcn_fence(__ATOMIC_ACQUIRE, "agent");
            asm volatile("s_waitcnt vmcnt(0)" ::: "memory");
        }
    }
    __syncthreads();
}
#ifndef ATT_EARLY_EXIT
#define ATT_EARLY_EXIT 1
#endif
constexpr int KROW = 272, VROW = 144;
constexpr int KBUF = 64 * KROW, VBUF = 128 * VROW;
constexpr int AT_K = 0, AT_V = 2 * KBUF, AT_FLAG = 2 * KBUF + 2 * VBUF;
constexpr float LOG2E = 1.4426950408889634f;
constexpr float EXIT_THR = 7.5231638e-37f;
constexpr int LTOT = SEQ + NMETA;

__device__ __forceinline__ const bf16* tok_row(const bf16* P, const bf16* Pmeta, int pos) { return pos < NMETA ? Pmeta + (size_t)pos * INC : P + (size_t)(pos - NMETA) * INC; }
__device__ __forceinline__ bf16x8 pack8(float a0, float a1, float a2, float a3, float a4, float a5, float a6, float a7) {
    v4u w; w.x = pk2(a0, a1); w.y = pk2(a2, a3); w.z = pk2(a4, a5); w.w = pk2(a6, a7); return __builtin_bit_cast(bf16x8, w); }

__device__ __forceinline__ void conv_meta_prep(bf16* __restrict__ P, const bf16* __restrict__ Pmeta, int lane) {
#pragma unroll
    for (int pos = NMETA - 2; pos < NMETA; ++pos)
#pragma unroll
        for (int j = 0; j < 2; ++j) { const int ch = 512 * j + 8 * lane; const bf16* r = Pmeta + (size_t)pos * INC + 4096 + (ch >> 7) * 256 + (ch & 127);
            const v4u a = *(const v4u*)r, b = *(const v4u*)(r + 128); v4u w;
#pragma unroll
            for (int c = 0; c < 4; ++c) w[c] = pk2(bflo(a[c]) * bflo(b[c]), bfhi(a[c]) * bfhi(b[c]));
            *(v4u*)(P + (ptrdiff_t)(pos - NMETA) * INC + 4096 + ch) = w; }
}
__device__ __forceinline__ void conv_row(int t, const bf16* P, const float* __restrict__ g_c, const float* __restrict__ cw, bf16* __restrict__ OC, int lane) {
    float y[16]; float ss = 0.f;
    v4u rb[2], r0[2], r1[2], r2[2];
#pragma unroll
    for (int j = 0; j < 2; ++j) { const bf16* p = P + (ptrdiff_t)t * INC + 512 * j + 8 * lane;
        rb[j] = __builtin_nontemporal_load((const v4u*)(p + 3 * AW)); r0[j] = *(const v4u*)(p + 4096); r1[j] = *(const v4u*)(p - INC + 4096); r2[j] = *(const v4u*)(p - 2 * INC + 4096); }
#pragma unroll
    for (int j = 0; j < 2; ++j) { const int ch = 512 * j + 8 * lane;
        float w0[8], w1[8], w2[8];
        { const f32x4 a = *(const f32x4*)(cw + ch), b = *(const f32x4*)(cw + ch + 4); w0[0] = a[0]; w0[1] = a[1]; w0[2] = a[2]; w0[3] = a[3]; w0[4] = b[0]; w0[5] = b[1]; w0[6] = b[2]; w0[7] = b[3]; }
        { const f32x4 a = *(const f32x4*)(cw + CWID + ch), b = *(const f32x4*)(cw + CWID + ch + 4); w1[0] = a[0]; w1[1] = a[1]; w1[2] = a[2]; w1[3] = a[3]; w1[4] = b[0]; w1[5] = b[1]; w1[6] = b[2]; w1[7] = b[3]; }
        { const f32x4 a = *(const f32x4*)(cw + 2 * CWID + ch), b = *(const f32x4*)(cw + 2 * CWID + ch + 4); w2[0] = a[0]; w2[1] = a[1]; w2[2] = a[2]; w2[3] = a[3]; w2[4] = b[0]; w2[5] = b[1]; w2[6] = b[2]; w2[7] = b[3]; }
#pragma unroll
        for (int c = 0; c < 4; ++c) {
            const float lo = bflo(rb[j][c]) * (w0[2 * c] * bflo(r2[j][c]) + w1[2 * c] * bflo(r1[j][c]) + w2[2 * c] * bflo(r0[j][c]));
            const float hh = bfhi(rb[j][c]) * (w0[2 * c + 1] * bfhi(r2[j][c]) + w1[2 * c + 1] * bfhi(r1[j][c]) + w2[2 * c + 1] * bfhi(r0[j][c]));
            y[8 * j + 2 * c] = lo; y[8 * j + 2 * c + 1] = hh; ss += lo * lo + hh * hh; }
        asm volatile("" ::: "memory"); }
    const float rs = 1.0f / sqrtf(wave_sum(ss) * (1.0f / CWID) + EPS);
#pragma unroll
    for (int j = 0; j < 2; ++j) { const int ch = 512 * j + 8 * lane; const f32x4 ga = *(const f32x4*)(g_c + ch), gb = *(const f32x4*)(g_c + ch + 4);
        v4u w; w.x = pk2(y[8 * j] * rs * ga[0], y[8 * j + 1] * rs * ga[1]); w.y = pk2(y[8 * j + 2] * rs * ga[2], y[8 * j + 3] * rs * ga[3]);
        w.z = pk2(y[8 * j + 4] * rs * gb[0], y[8 * j + 5] * rs * gb[1]); w.w = pk2(y[8 * j + 6] * rs * gb[2], y[8 * j + 7] * rs * gb[3]);
        *(v4u*)(OC + (size_t)t * DM + AW + ch) = w; }
}

__device__ __forceinline__ void attn_unit(int h, int qb, const bf16* P, const bf16* __restrict__ Pmeta, const float* __restrict__ gq, const float* __restrict__ gk,
                                          const float* __restrict__ g_a, bf16* __restrict__ OC, float* __restrict__ ssa, LAS unsigned char* lds,
                                          int conv_t0, int conv_n, const float* __restrict__ g_c, const float* __restrict__ cw) {
    int tid_ = threadIdx.x; asm volatile("" : "+v"(tid_));
    const int tid = tid_, lane = tid & 63, r32 = lane & 31, hi = lane >> 5;
    const int wid = __builtin_amdgcn_readfirstlane(tid >> 6);
    const int tq = 256 * qb + 32 * wid + r32, qpos = NMETA + tq;
    const int kchunk = tid & 15, kkey0 = tid >> 4;
    float gkv[8];
    { const f32x4 a = *(const f32x4*)(gk + 8 * kchunk), b = *(const f32x4*)(gk + 8 * kchunk + 4); gkv[0] = a[0]; gkv[1] = a[1]; gkv[2] = a[2]; gkv[3] = a[3]; gkv[4] = b[0]; gkv[5] = b[1]; gkv[6] = b[2]; gkv[7] = b[3]; }
    const int vcol = 16 * (lane >> 4) + 8 * ((lane >> 2) & 1) + (lane & 3) + 4 * ((lane >> 3) & 1);
    v4u kreg[2], vreg[2];
#define AT_LOADT(k0_) do { \
        _Pragma("unroll") for (int j_ = 0; j_ < 2; ++j_) { int pos_ = (k0_) + kkey0 + 32 * j_; pos_ = pos_ < 0 ? 0 : pos_; \
            kreg[j_] = *(const v4u*)(tok_row(P, Pmeta, pos_) + AW + h * HD + 8 * kchunk); } \
        { int pos_ = (k0_) + lane; pos_ = pos_ < 0 ? 0 : pos_; const bf16* r_ = tok_row(P, Pmeta, pos_) + 2 * AW + h * HD + 16 * wid; \
            vreg[0] = *(const v4u*)r_; vreg[1] = *(const v4u*)(r_ + 8); } } while (0)
#define AT_STORET(buf_) do { \
        _Pragma("unroll") for (int j_ = 0; j_ < 2; ++j_) { float f_[8]; float s_ = 0.f; \
            _Pragma("unroll") for (int c_ = 0; c_ < 4; ++c_) { f_[2 * c_] = bflo(kreg[j_][c_]); f_[2 * c_ + 1] = bfhi(kreg[j_][c_]); s_ += f_[2 * c_] * f_[2 * c_] + f_[2 * c_ + 1] * f_[2 * c_ + 1]; } \
            s_ = row16_sum(s_); \
            const float rs_ = 1.0f / sqrtf(s_ * (1.0f / HD) + EPS); \
            v4u w_; w_.x = pk2(f_[0] * rs_ * gkv[0], f_[1] * rs_ * gkv[1]); w_.y = pk2(f_[2] * rs_ * gkv[2], f_[3] * rs_ * gkv[3]); \
            w_.z = pk2(f_[4] * rs_ * gkv[4], f_[5] * rs_ * gkv[5]); w_.w = pk2(f_[6] * rs_ * gkv[6], f_[7] * rs_ * gkv[7]); \
            *(LAS v4u*)(lds + AT_K + (buf_) * KBUF + (kkey0 + 32 * j_) * KROW + kchunk * 16) = w_; } \
        _Pragma("unroll") for (int j_ = 0; j_ < 2; ++j_) \
            _Pragma("unroll") for (int i_ = 0; i_ < 8; ++i_) { const unsigned d_ = vreg[j_][i_ >> 1]; \
                *(LAS unsigned short*)(lds + AT_V + (buf_) * VBUF + (8 * (2 * wid + j_) + i_) * VROW + 2 * vcol) = (unsigned short)((i_ & 1) ? (d_ >> 16) : (d_ & 0xffffu)); } } while (0)

    f32x16 o[4];
#pragma unroll
    for (int d0 = 0; d0 < 4; ++d0)
#pragma unroll
        for (int r = 0; r < 16; ++r) o[d0][r] = 0.f;
    if (conv_t0 == 0) conv_meta_prep(const_cast<bf16*>(P), Pmeta, lane);
    float carry = 1.f; int wdone = 0; int crem = conv_n;
    const int Q0 = NMETA + 256 * qb, KTOP = Q0 + 256, NT = (KTOP + 63) / 64, Qw = Q0 + 32 * wid;
    LAS int* flags = (LAS int*)(lds + AT_FLAG);
    AT_LOADT(KTOP - 64);
    bf16x8 qf[8];
    {
        const bf16* qrow = P + (size_t)tq * INC + h * HD + 8 * hi;
        v4u raw[8]; float ss = 0.f;
#pragma unroll
        for (int d0 = 0; d0 < 8; ++d0) raw[d0] = __builtin_nontemporal_load((const v4u*)(qrow + 16 * d0));
#pragma unroll
        for (int d0 = 0; d0 < 8; ++d0)
#pragma unroll
            for (int c = 0; c < 4; ++c) { const float a = bflo(raw[d0][c]), b = bfhi(raw[d0][c]); ss += a * a + b * b; }
        ss += __shfl_xor(ss, 32);
        const float sc = (1.0f / sqrtf(ss * (1.0f / HD) + EPS)) * (LOG2E * 0.08838834764831845f);
#pragma unroll
        for (int d0 = 0; d0 < 8; ++d0) { const f32x4 g0 = *(const f32x4*)(gq + 16 * d0 + 8 * hi), g1 = *(const f32x4*)(gq + 16 * d0 + 8 * hi + 4);
            qf[d0] = pack8(bflo(raw[d0][0]) * sc * g0[0], bfhi(raw[d0][0]) * sc * g0[1], bflo(raw[d0][1]) * sc * g0[2], bfhi(raw[d0][1]) * sc * g0[3],
                           bflo(raw[d0][2]) * sc * g1[0], bfhi(raw[d0][2]) * sc * g1[1], bflo(raw[d0][3]) * sc * g1[2], bfhi(raw[d0][3]) * sc * g1[3]); }
    }
    AT_STORET(0);
    __syncthreads();
    for (int it = 0; it < NT; ++it) {
        const int k0 = KTOP - 64 * (it + 1), buf = it & 1; const bool more = it + 1 < NT;
        if (more) AT_LOADT(k0 - 64);
        if (!wdone && k0 < Qw + 31) {
            const LAS unsigned char* kb = lds + AT_K + buf * KBUF + r32 * KROW + hi * 16;
            const bool needmask = (k0 + 63 >= Qw) || (k0 < 0);
            float run = carry;
            bf16x8 pa[4];
#pragma unroll
            for (int blk = 1; blk >= 0; --blk) {
                f32x16 p;
#pragma unroll
                for (int r = 0; r < 16; ++r) p[r] = 0.f;
#pragma unroll
                for (int d0 = 0; d0 < 8; ++d0) { const bf16x8 ka = *(const LAS bf16x8*)(kb + blk * 32 * KROW + d0 * 32); p = __builtin_amdgcn_mfma_f32_32x32x16_bf16(ka, qf[d0], p, 0, 0, 0); }
                if (needmask) {
#pragma unroll
                    for (int r = 0; r < 16; ++r) { const int key = k0 + 32 * blk + crow(r, hi); if (key >= qpos || key < 0) p[r] = -1e30f; }
                }
                float kp[16];
#pragma unroll
                for (int r = 0; r < 16; ++r) { const float e = __builtin_amdgcn_exp2f(__builtin_fminf(p[r], 120.f)); const float sv = __builtin_amdgcn_rcpf(1.0f + e); kp[r] = sv; p[r] = e * sv; }
                float gs[4], pg[4];
#pragma unroll
                for (int g = 0; g < 4; ++g) { const float gp = (kp[4 * g] * kp[4 * g + 1]) * (kp[4 * g + 2] * kp[4 * g + 3]);
                    const auto rr = __builtin_amdgcn_permlane32_swap(__float_as_uint(gp), __float_as_uint(gp), false, false);
                    pg[g] = __uint_as_float(rr[1]); gs[g] = __uint_as_float(rr[0]) * __uint_as_float(rr[1]); }
#pragma unroll
                for (int g = 3; g >= 0; --g) { float c = hi ? run : run * pg[g];
#pragma unroll
                    for (int i = 3; i >= 0; --i) { const int r = 4 * g + i; const float wv = p[r] * c; c *= kp[r]; p[r] = wv; }
                    run *= gs[g]; }
                pa[2 * blk] = pack8(p[0], p[1], p[2], p[3], p[4], p[5], p[6], p[7]); pa[2 * blk + 1] = pack8(p[8], p[9], p[10], p[11], p[12], p[13], p[14], p[15]);
            }
            carry = run;
            const LAS unsigned char* vb = lds + AT_V + buf * VBUF + r32 * VROW + hi * 16;
#pragma unroll
            for (int d0 = 0; d0 < 4; ++d0)
#pragma unroll
                for (int ks = 0; ks < 4; ++ks) { const bf16x8 vf = *(const LAS bf16x8*)(vb + d0 * 32 * VROW + ks * 32); o[d0] = __builtin_amdgcn_mfma_f32_32x32x16_bf16(pa[ks], vf, o[d0], 0, 0, 0); }
#if ATT_EARLY_EXIT
            wdone = __all(carry < EXIT_THR) ? 1 : 0;
#endif
        } else if (crem > 0) { conv_row(conv_t0 + conv_n - crem, P, g_c, cw, OC, lane); --crem; }
        if (lane == 0) flags[buf * 8 + wid] = wdone;
        if (more) AT_STORET(buf ^ 1);
        __syncthreads();
        int all = 1;
#pragma unroll
        for (int w = 0; w < 8; ++w) all &= flags[buf * 8 + w];
        if (all) break;
    }
    for (; crem > 0; --crem) conv_row(conv_t0 + conv_n - crem, P, g_c, cw, OC, lane);
    const int tok0 = 256 * qb + 32 * wid;
    LAS unsigned char* stg = lds + wid * 8704;
    float ga[4];
#pragma unroll
    for (int d0 = 0; d0 < 4; ++d0) ga[d0] = g_a[h * HD + 32 * d0 + r32];
#pragma unroll
    for (int r = 0; r < 16; ++r) {
        float s = (o[0][r] * o[0][r] + o[1][r] * o[1][r]) + (o[2][r] * o[2][r] + o[3][r] * o[3][r]);
        s = half32_sum_hi(s);
        if (r32 == 16) atomicAdd(ssa + tok0 + crow(r, hi), s);
#pragma unroll
        for (int d0 = 0; d0 < 4; ++d0) *(LAS unsigned short*)(stg + crow(r, hi) * 272 + (32 * d0 + r32) * 2) = (unsigned short)(pk2(o[d0][r] * ga[d0], 0.f) & 0xffffu);
    }
#pragma unroll
    for (int i = 0; i < 8; ++i) { const int chunk = i * 64 + lane, row = chunk >> 4, c16 = chunk & 15;
        const v4u v = *(const LAS v4u*)(stg + row * 272 + c16 * 16);
        *(v4u*)(OC + (size_t)(tok0 + row) * DM + h * HD + c16 * 8) = v; }
    __syncthreads();
#undef AT_LOADT
#undef AT_STORET
}

__global__ void __launch_bounds__(NWAVES * 64, 2) hymba_fwd(Args A) {
    extern __shared__ __attribute__((aligned(16))) unsigned char lds_raw[];
    LAS unsigned char* lds = (LAS unsigned char*)lds_raw;
    cg::grid_group grid = cg::this_grid();
    const int tid = threadIdx.x, lane = tid & 63, wave = __builtin_amdgcn_readfirstlane(tid >> 6);
    const int G = gridDim.x, gw = blockIdx.x * NWAVES + wave, NGW = G * NWAVES;
    unsigned char* ws = A.ws;
    bf16* WinT = (bf16*)(ws + WS_WIN); bf16* WoutT = (bf16*)(ws + WS_WOUT); bf16* WguT = (bf16*)(ws + WS_WGU); bf16* WdT = (bf16*)(ws + WS_WD);
    bf16* XN = (bf16*)((unsigned char*)A.out + OUT_XN); bf16* XNmeta = (bf16*)(ws + WS_XNMETA); bf16* Pmeta = (bf16*)(ws + WS_PMETA); float* ss2 = (float*)(ws + WS_SS2); float* ssa = (float*)(ws + WS_SSA);
    bf16* P = (bf16*)(ws + WS_P) + 2 * INC; bf16* HFF = (bf16*)(ws + WS_P); bf16* OC = (bf16*)(ws + WS_OC); bf16* A2 = (bf16*)(ws + WS_WIN);

    unsigned* barw = (unsigned*)(ws + WS_BAR);
    volatile LAS unsigned* bst = (volatile LAS unsigned*)(lds + 131072 + 64);
    if (tid < 2) bst[tid] = 0u;
    __syncthreads();
    const XcdBarrier bar = xcd_barrier_post(barw, bst);
    if (A.ws == nullptr) grid.sync();
    p0_prologue(A, lds, gw, NGW, wave, lane);
    xcd_barrier(bar);

    {
        pg8::Gemm g{XN, WinT, SEQ, INC, DM}; pg8::StaticOrder S; S.init(SEQ, INC, G, (int)blockIdx.x);
        pg8::EpiIn E{P, INC};
        pg8::gemm_phase<pg8::EpiIn, pg8::StaticOrder, PG8_ALIGN, PG8_SP2>(lds, g, S, E);
        for (int tb = blockIdx.x; tb < 192; tb += G) p1_meta(XNmeta, WinT, Pmeta, lds, tb, wave, lane);
    }
    xcd_barrier(bar);

    for (int u = blockIdx.x; u < NH * (SEQ / 256); u += G) {
        const int c0 = wave < 2 ? 3 * wave : (wave < 6 ? 6 + 4 * (wave - 2) : 22 + 5 * (wave - 6));
        attn_unit(u & 7, (SEQ / 256 - 1) - (u >> 3), P, Pmeta, A.in[4], A.in[5], A.in[7], OC, ssa, lds, 32 * u + c0, wave < 2 ? 3 : (wave < 6 ? 4 : 5), A.in[8], A.in[6]);
    }
    xcd_barrier(bar);

    {
        pg8::Gemm g{OC, WoutT, SEQ, DM, DM}; pg8::StaticOrder S; S.init(SEQ, DM, G, (int)blockIdx.x);
        pg8::EpiRes1 E{XN, (const float*)(ws + WS_IRS1), A.in[2], A2, A.in[10], ss2, DM, ssa, 1.0f / AW, EPS};
        pg8::gemm_phase<pg8::EpiRes1, pg8::StaticOrder, PG8_ALIGN, PG8_SP2>(lds, g, S, E);
    }
    xcd_barrier(bar);

    {
        pg8::Gemm g{A2, WguT, SEQ, 2 * DFF, DM}; pg8::StaticOrder S; S.init(SEQ, 2 * DFF, G, (int)blockIdx.x);
        pg8::EpiSwiGLU E{HFF, DFF, ss2, 1.0f / DM, EPS};
        pg8::gemm_phase<pg8::EpiSwiGLU, pg8::StaticOrder, PG8_ALIGN, PG8_SP2>(lds, g, S, E);
        { const int nwg = (SEQ / 256) * (2 * DFF / 256), rem = nwg % G, first = rem ? rem : 0, nshort = G - first;
          if ((int)blockIdx.x >= first) wd_convert(A.in[13], WdT, lds, ((int)blockIdx.x - first) * NWAVES + wave, nshort * NWAVES, wave, lane); }
    }
    xcd_barrier(bar);

    {
        pg8::Gemm g{HFF, WdT, SEQ, DM, DFF}; pg8::StaticOrder S; S.init(SEQ, DM, G, (int)blockIdx.x);
        pg8::EpiRes2 E{A2, A.in[10], A.out, DM};
        pg8::gemm_phase<pg8::EpiRes2, pg8::StaticOrder, PG8_ALIGN, PG8_SP2>(lds, g, S, E);
    }
}

extern "C" void kernel_launch(void* const* d_in, const int* in_sizes, int n_in, void* d_out, int out_size, void* d_ws, size_t ws_size, hipStream_t stream) {
    static int grid = 0;
    if (grid == 0) {
        if (n_in != 14 || out_size != SEQ * DM || ws_size < WS_END) { fprintf(stderr, "kernel_launch: unexpected shapes (n_in %d out %d ws %zu)\n", n_in, out_size, ws_size); grid = -1; return; }
        int dev = 0, cus = 0, per_cu = 0;
        hipGetDevice(&dev); hipDeviceGetAttribute(&cus, hipDeviceAttributeMultiprocessorCount, dev);
        if (hipFuncSetAttribute((const void*)hymba_fwd, hipFuncAttributeMaxDynamicSharedMemorySize, LDS_BYTES) != hipSuccess) { fprintf(stderr, "kernel_launch: hipFuncSetAttribute failed\n"); grid = -1; return; }
        if (hipOccupancyMaxActiveBlocksPerMultiprocessor(&per_cu, (const void*)hymba_fwd, NWAVES * 64, LDS_BYTES) != hipSuccess || per_cu < 1) { fprintf(stderr, "kernel_launch: occupancy query says %d\n", per_cu); per_cu = 1; }
        (void)hipGetLastError();
        grid = cus;
        if (grid > 256) grid = 256;
    }
    if (grid < 0) return;
    if (hipMemsetAsync((char*)d_ws + WS_BAR, 0, XCD_BAR_WORDS * 4, stream) != hipSuccess) { fprintf(stderr, "kernel_launch: memset of barrier words failed\n"); return; }
    Args a{};
    for (int i = 0; i < 14; ++i) a.in[i] = (const float*)d_in[i];
    a.out = (float*)d_out; a.ws = (unsigned char*)d_ws;
    void* args[] = {&a};
    hipError_t e = hipLaunchCooperativeKernel((const void*)hymba_fwd, dim3(grid), dim3(NWAVES * 64), args, LDS_BYTES, stream);
    if (e != hipSuccess) fprintf(stderr, "cooperative launch failed: %s (grid %d)\n", hipGetErrorString(e), grid);
}
```

```cpp
#include <hip/hip_runtime.h>
#include <hip/hip_cooperative_groups.h>
#include <cstdio>
#include <cstdint>
namespace cg = cooperative_groups;
namespace pg8 {
#define PG8_LAS __attribute__((address_space(3)))
typedef unsigned short bf16_t;
typedef short bf16x8 __attribute__((ext_vector_type(8)));
typedef float f32x4 __attribute__((ext_vector_type(4)));
typedef unsigned u32x4 __attribute__((ext_vector_type(4)));
constexpr int BM = 256, BK = 64, HALF = 128, HTB = HALF * BK * 2  , STAGE_BYTES = 8 * HTB, NXCD = 8, WGM = 8;

__host__ __device__ __forceinline__ int lds_byte(int r, int c) { const int st = (r >> 4) * 2 + (c >> 5), rr = r & 15, cc = c & 31, ob = rr * 64 + cc * 2; return st * 1024 + (ob ^ (((ob >> 9) & 1) << 5)); }
__host__ __device__ __forceinline__ void stage_rc(int b, int& R, int& C) { const int st = b / 1024, sb = b % 1024, swz = sb ^ (((sb >> 9) & 1) << 5); R = (st >> 1) * 16 + swz / 64; C = (st & 1) * 32 + (swz % 64) / 2; }
__host__ __device__ __forceinline__ int perm32(int rho) { const int n = rho >> 4, i = rho & 15; return 8 * (i >> 2) + 4 * n + (i & 3); }

struct Unit { int pm, pn; };
struct Gemm { const bf16_t* A; const bf16_t* Bt; int M, N, K; };

struct StaticOrder {
    int nM, nN, nwg, G, c;
    __host__ __device__ void init(int M, int N, int G_, int c_) { nM = M / BM; nN = N / BM; nwg = nM * nN; G = G_; c = c_; }
    __host__ __device__ bool next(int i, Unit& u) const {
        const long L = (long)i * G + c; if (L >= nwg) return false;
        int wgid = (int)L; { const int q = nwg / NXCD, r = nwg % NXCD, xcd = wgid % NXCD, off = wgid / NXCD; wgid = (xcd < r ? xcd * (q + 1) : r * (q + 1) + (xcd - r) * q) + off; }
        const int nig = WGM * nN, gid = wgid / nig, fm = gid * WGM, gsz = (nM - fm) < WGM ? (nM - fm) : WGM;
        u.pm = fm + ((wgid % nig) % gsz); u.pn = (wgid % nig) / gsz; return true;
    }
    __device__ __forceinline__ void a_ready(const Unit&) const {}
    __device__ __forceinline__ void done(const Unit&) const {}
};

__device__ __forceinline__ unsigned cvt_pk_bf16(float lo, float hi) { unsigned r; asm volatile("v_cvt_pk_bf16_f32 %0, %1, %2" : "=v"(r) : "v"(lo), "v"(hi)); return r; }
typedef float f32x2 __attribute__((ext_vector_type(2)));
__device__ __forceinline__ f32x2 gelu_pk(f32x2 v) {
    const f32x2 av = __builtin_elementwise_abs(v), d = av * 0.2316418882f + 1.0f;
    f32x2 t; t.x = __builtin_amdgcn_rcpf(d.x); t.y = __builtin_amdgcn_rcpf(d.y);
    f32x2 q = t * 0.5307027145f + (-0.7265760135f); q = q * t + 0.7107068705f; q = q * t + (-0.142248368f); q = q * t + 0.127414796f; q = q * t;
    const f32x2 s = (v * v) * (-0.72134752044f);
    f32x2 e; e.x = __builtin_amdgcn_exp2f(s.x); e.y = __builtin_amdgcn_exp2f(s.y);
    const f32x2 m = v * (q * e), r = v - m;
    f32x2 o; o.x = v.x < 0.f ? m.x : r.x; o.y = v.y < 0.f ? m.y : r.y; return o;
}

template <int ACT  > struct EpiBf16 {
    static constexpr bool PERM = true, AFTER_DRAIN = false; static constexpr int KSPLIT = 0; static_assert(ACT == 0 || ACT == 1, "EpiBf16: ACT is 0 (none) or 1 (gelu_pk)");
    bf16_t* O; int ldc; const float* bias; int split_cols; size_t split_stride; float scale0;
    __device__ __forceinline__ void operator()(const f32x4 (&acc)[2][2][4][2], const Unit& u, int wr, int wc, int fr, int fq) const {
        const int row0 = u.pm * BM + wr * 64 + fr; int colt = u.pn * BM; bf16_t* base = O;
        float sc = 1.f; if (split_cols) { const int t = colt / split_cols; base += (size_t)t * split_stride; colt -= t * split_cols; if (t == 0) sc = scale0; }
        const int col0 = colt + wc * 32 + 8 * fq, bcol0 = u.pn * BM + wc * 32 + 8 * fq;
        f32x4 bv[2][2];
#pragma unroll
        for (int bj = 0; bj < 2; ++bj)
#pragma unroll
            for (int n = 0; n < 2; ++n) bv[bj][n] = bias ? *(const f32x4*)(bias + bcol0 + bj * HALF + 4 * n) : (f32x4){0.f, 0.f, 0.f, 0.f};
#pragma unroll
        for (int ai = 0; ai < 2; ++ai)
#pragma unroll
            for (int m = 0; m < 4; ++m) { bf16_t* rowp = base + (size_t)(row0 + ai * HALF + m * 16) * ldc + col0;
#pragma unroll
                for (int bj = 0; bj < 2; ++bj) { f32x4 v0 = acc[ai][bj][m][0] + bv[bj][0], v1 = acc[ai][bj][m][1] + bv[bj][1];
                    if (ACT == 1) { f32x2 a = gelu_pk((f32x2){v0[0], v0[1]}), b = gelu_pk((f32x2){v0[2], v0[3]}), c = gelu_pk((f32x2){v1[0], v1[1]}), d = gelu_pk((f32x2){v1[2], v1[3]});
                        v0 = (f32x4){a.x, a.y, b.x, b.y}; v1 = (f32x4){c.x, c.y, d.x, d.y}; }
                    v0 = v0 * sc; v1 = v1 * sc; u32x4 w; w.x = cvt_pk_bf16(v0[0], v0[1]); w.y = cvt_pk_bf16(v0[2], v0[3]); w.z = cvt_pk_bf16(v1[0], v1[1]); w.w = cvt_pk_bf16(v1[2], v1[3]);
                    *(u32x4*)(rowp + bj * HALF) = w; } }
    }
};
typedef unsigned u32x2 __attribute__((ext_vector_type(2)));
struct EpiRes1 {
    static constexpr bool PERM = true, AFTER_DRAIN = false; static constexpr int KSPLIT = 16;
    const bf16_t* xn; const float* irs1; const float* gmix; bf16_t* a2; const float* g; float* ss; int ldc; const float* ssa; float inv_na, eps;
    __device__ __forceinline__ void ksplit(f32x4 (&acc)[2][2][4][2], const Unit& u, int wr, int wc, int fr, int fq) const {
        float rs[2][4];
#pragma unroll
        for (int ai = 0; ai < 2; ++ai)
#pragma unroll
            for (int m = 0; m < 4; ++m) rs[ai][m] = ssa[u.pm * BM + ai * HALF + wr * 64 + m * 16 + fr];
#pragma unroll
        for (int ai = 0; ai < 2; ++ai)
#pragma unroll
            for (int m = 0; m < 4; ++m) { const float r = 1.0f / sqrtf(rs[ai][m] * inv_na + eps);
#pragma unroll
                for (int bj = 0; bj < 2; ++bj)
#pragma unroll
                    for (int n = 0; n < 2; ++n) acc[ai][bj][m][n] *= r; }
    }
    __device__ __forceinline__ void operator()(const f32x4 (&acc)[2][2][4][2], const Unit& u, int wr, int wc, int fr, int fq) const {
        const int col0 = u.pn * BM + wc * 32 + 8 * fq;
        f32x4 gv[2][2], gi[2][2];
#pragma unroll
        for (int bj = 0; bj < 2; ++bj)
#pragma unroll
            for (int n = 0; n < 2; ++n) { gv[bj][n] = *(const f32x4*)(g + col0 + bj * HALF + 4 * n); const f32x4 gm = *(const f32x4*)(gmix + col0 + bj * HALF + 4 * n);
                gi[bj][n] = (f32x4){1.0f / gm[0], 1.0f / gm[1], 1.0f / gm[2], 1.0f / gm[3]}; }
#pragma unroll
        for (int ai = 0; ai < 2; ++ai)
#pragma unroll
            for (int m = 0; m < 4; ++m) { const int row = u.pm * BM + ai * HALF + wr * 64 + m * 16 + fr; const size_t off = (size_t)row * ldc + col0; float s = 0.f; const float ir = irs1[row];
#pragma unroll
                for (int bj = 0; bj < 2; ++bj) { const u32x4 xw = *(const u32x4*)(xn + off + bj * HALF);
                    const f32x4 h0 = (f32x4){__uint_as_float(xw.x << 16), __uint_as_float(xw.x & 0xffff0000u), __uint_as_float(xw.y << 16), __uint_as_float(xw.y & 0xffff0000u)} * gi[bj][0] * ir + acc[ai][bj][m][0];
                    const f32x4 h1 = (f32x4){__uint_as_float(xw.z << 16), __uint_as_float(xw.z & 0xffff0000u), __uint_as_float(xw.w << 16), __uint_as_float(xw.w & 0xffff0000u)} * gi[bj][1] * ir + acc[ai][bj][m][1];
                    s += ((h0[0] * h0[0] + h0[1] * h0[1]) + (h0[2] * h0[2] + h0[3] * h0[3])) + ((h1[0] * h1[0] + h1[1] * h1[1]) + (h1[2] * h1[2] + h1[3] * h1[3]));
                    const f32x4 a0 = h0 * gv[bj][0], a1 = h1 * gv[bj][1];
                    u32x4 w; w.x = cvt_pk_bf16(a0[0], a0[1]); w.y = cvt_pk_bf16(a0[2], a0[3]); w.z = cvt_pk_bf16(a1[0], a1[1]); w.w = cvt_pk_bf16(a1[2], a1[3]);
                    *(u32x4*)(a2 + off + bj * HALF) = w; }
                s += __shfl_xor(s, 16); s += __shfl_xor(s, 32);
                if (fq == 0) atomicAdd(ss + row, s);
                if (m & 1) asm volatile("" ::: "memory"); }
    }
};
struct EpiSwiGLU {
    static constexpr bool PERM = true, AFTER_DRAIN = false; static constexpr int KSPLIT = 0;
    bf16_t* O; int ldc; const float* ss; float inv_n, eps;
    __device__ __forceinline__ void operator()(const f32x4 (&acc)[2][2][4][2], const Unit& u, int wr, int wc, int fr, int fq) const {
        const int col0 = u.pn * HALF + wc * 32 + 8 * fq;
#pragma unroll
        for (int ai = 0; ai < 2; ++ai)
#pragma unroll
            for (int m = 0; m < 4; ++m) { const int row = u.pm * BM + ai * HALF + wr * 64 + m * 16 + fr; const float r = __builtin_amdgcn_rsqf(ss[row] * inv_n + eps);
                float hv[8];
#pragma unroll
                for (int n = 0; n < 2; ++n)
#pragma unroll
                    for (int i = 0; i < 4; ++i) { const float gt = acc[ai][0][m][n][i] * r, up = acc[ai][1][m][n][i] * r;
                        const float sg = gt * __builtin_amdgcn_rcpf(1.0f + __builtin_amdgcn_exp2f(-1.4426950408889634f * gt)); hv[n * 4 + i] = sg * up; }
                u32x4 w; w.x = cvt_pk_bf16(hv[0], hv[1]); w.y = cvt_pk_bf16(hv[2], hv[3]); w.z = cvt_pk_bf16(hv[4], hv[5]); w.w = cvt_pk_bf16(hv[6], hv[7]);
                *(u32x4*)(O + (size_t)row * ldc + col0) = w; }
    }
};
struct EpiRes2 {
    static constexpr bool PERM = true, AFTER_DRAIN = false; static constexpr int KSPLIT = 0;
    const bf16_t* a2; const float* g; float* out; int ldc;
    __device__ __forceinline__ void operator()(const f32x4 (&acc)[2][2][4][2], const Unit& u, int wr, int wc, int fr, int fq) const {
        const int col0 = u.pn * BM + wc * 32 + 8 * fq;
        f32x4 gi[2][2];
#pragma unroll
        for (int bj = 0; bj < 2; ++bj)
#pragma unroll
            for (int n = 0; n < 2; ++n) { const f32x4 gv = *(const f32x4*)(g + col0 + bj * HALF + 4 * n); gi[bj][n] = (f32x4){1.0f / gv[0], 1.0f / gv[1], 1.0f / gv[2], 1.0f / gv[3]}; }
#pragma unroll
        for (int ai = 0; ai < 2; ++ai)
#pragma unroll
            for (int m = 0; m < 4; ++m) { const int row = u.pm * BM + ai * HALF + wr * 64 + m * 16 + fr; const size_t off = (size_t)row * ldc + col0;
#pragma unroll
                for (int bj = 0; bj < 2; ++bj) { const u32x4 w = *(const u32x4*)(a2 + off + bj * HALF);
                    const f32x4 h0 = (f32x4){__uint_as_float(w.x << 16), __uint_as_float(w.x & 0xffff0000u), __uint_as_float(w.y << 16), __uint_as_float(w.y & 0xffff0000u)} * gi[bj][0];
                    const f32x4 h1 = (f32x4){__uint_as_float(w.z << 16), __uint_as_float(w.z & 0xffff0000u), __uint_as_float(w.w << 16), __uint_as_float(w.w & 0xffff0000u)} * gi[bj][1];
                    *(f32x4*)(out + off + bj * HALF) = h0 + acc[ai][bj][m][0]; *(f32x4*)(out + off + bj * HALF + 4) = h1 + acc[ai][bj][m][1]; }
                if (m & 1) asm volatile("" ::: "memory"); }
    }
};
struct EpiIn {
    static constexpr bool PERM = true, AFTER_DRAIN = false; static constexpr int KSPLIT = 0;
    bf16_t* O; int ldc;
    __device__ __forceinline__ void operator()(const f32x4 (&acc)[2][2][4][2], const Unit& u, int wr, int wc, int fr, int fq) const {
        const int row0 = u.pm * BM + wr * 64 + fr;
        if (u.pn < 16) {
            const int col0 = u.pn * BM + wc * 32 + 8 * fq;
#pragma unroll
            for (int ai = 0; ai < 2; ++ai)
#pragma unroll
                for (int m = 0; m < 4; ++m) { bf16_t* rowp = O + (size_t)(row0 + ai * HALF + m * 16) * ldc + col0;
#pragma unroll
                    for (int bj = 0; bj < 2; ++bj) { const f32x4 v0 = acc[ai][bj][m][0], v1 = acc[ai][bj][m][1];
                        u32x4 w; w.x = cvt_pk_bf16(v0[0], v0[1]); w.y = cvt_pk_bf16(v0[2], v0[3]); w.z = cvt_pk_bf16(v1[0], v1[1]); w.w = cvt_pk_bf16(v1[2], v1[3]);
                        *(u32x4*)(rowp + bj * HALF) = w; } }
        } else {
            const int col0 = 4096 + (u.pn - 16) * HALF + wc * 32 + 8 * fq;
#pragma unroll
            for (int ai = 0; ai < 2; ++ai)
#pragma unroll
                for (int m = 0; m < 4; ++m) { const f32x4 v0 = acc[ai][0][m][0] * acc[ai][1][m][0], v1 = acc[ai][0][m][1] * acc[ai][1][m][1];
                    u32x4 w; w.x = cvt_pk_bf16(v0[0], v0[1]); w.y = cvt_pk_bf16(v0[2], v0[3]); w.z = cvt_pk_bf16(v1[0], v1[1]); w.w = cvt_pk_bf16(v1[2], v1[3]);
                    *(u32x4*)(O + (size_t)(row0 + ai * HALF + m * 16) * ldc + col0) = w; }
        }
    }
};
template <class Epi, class Sched, bool ALIGN_EPI = false, bool SP2 = false>
__device__ __forceinline__ void gemm_phase(PG8_LAS unsigned char* lds, const Gemm g, const Sched& S, const Epi& E) {
    int tid_ = threadIdx.x; asm volatile("" : "+v"(tid_));
    const int tid = tid_, wid = __builtin_amdgcn_readfirstlane(tid >> 6), lane = tid & 63, wr = wid >> 2, wc = wid & 3, fr = lane & 15, fq = lane >> 4;
    const int K = g.K, nt = K / BK;
    unsigned voffA[2], voffB[2];
#pragma unroll
    for (int i = 0; i < 2; ++i) { int R, C; stage_rc(tid * 16 + i * 8192, R, C); const int Rb = Epi::PERM ? ((R & ~31) + perm32(R & 31)) : R;
        voffA[i] = (unsigned)(R * K + C) * 2u; voffB[i] = (unsigned)(Rb * K + C) * 2u; }
    const size_t kstep = (size_t)(BK * 2);
    const size_t hstep = (size_t)HALF * K * 2;
    const size_t tstep = 2 * hstep;
    const unsigned ldsw = (unsigned)wid * 1024u;
    const int aoff = lds_byte(wr * 64 + fr, fq * 8), boff = lds_byte(wc * 32 + fr, fq * 8);
#define PG8_SA(b, h) (((b) * 2 + (h)) * HTB)
#define PG8_SB(b, h) ((4 + (b) * 2 + (h)) * HTB)
#define PG8_STAGE(bufoff, gbase, voff) do { _Pragma("unroll") for (int _i = 0; _i < 2; ++_i) \
        __builtin_amdgcn_global_load_lds((const unsigned*)((const char*)(gbase) + (voff)[_i]), (PG8_LAS unsigned*)(lds + (bufoff) + ldsw + _i * 8192), 16, 0, 0); } while (0)
#define PG8_LDA(dst, b, h) do { _Pragma("unroll") for (int m = 0; m < 4; ++m) _Pragma("unroll") for (int k = 0; k < 2; ++k) dst[m][k] = *(const PG8_LAS bf16x8*)(lds + PG8_SA(b, h) + aoff + m * 2048 + k * 1024); } while (0)
#define PG8_LDB(dst, b, h) do { _Pragma("unroll") for (int n = 0; n < 2; ++n) _Pragma("unroll") for (int k = 0; k < 2; ++k) dst[n][k] = *(const PG8_LAS bf16x8*)(lds + PG8_SB(b, h) + boff + n * 2048 + k * 1024); } while (0)
#define PG8_MMA(ai, bj, At, Bt) do { __builtin_amdgcn_s_setprio(1); _Pragma("unroll") for (int m = 0; m < 4; ++m) _Pragma("unroll") for (int n = 0; n < 2; ++n) _Pragma("unroll") for (int k = 0; k < 2; ++k) \
        acc[ai][bj][m][n] = __builtin_amdgcn_mfma_f32_16x16x32_bf16(Bt[n][k], At[m][k], acc[ai][bj][m][n], 0, 0, 0); __builtin_amdgcn_s_setprio(0); } while (0)
#define PG8_WAIT_V(n) asm volatile("s_waitcnt vmcnt(" #n ")" ::: "memory")
#define PG8_WAIT_L(n) asm volatile("s_waitcnt lgkmcnt(" #n ")" ::: "memory")
#define PG8_BAR __builtin_amdgcn_s_barrier()
#define PG8_SCHED __builtin_amdgcn_sched_barrier(0)
    Unit cur, nxt; int ui = 0;
    if (!S.next(0, cur)) return;
    f32x4 acc[2][2][4][2];
#pragma unroll
    for (int a = 0; a < 2; ++a)
#pragma unroll
        for (int b = 0; b < 2; ++b)
#pragma unroll
            for (int m = 0; m < 4; ++m)
#pragma unroll
                for (int n = 0; n < 2; ++n) acc[a][b][m][n] = (f32x4){0.f, 0.f, 0.f, 0.f};
    bf16x8 At[4][2], B0[2][2], B1[2][2];
    const char* cA = (const char*)g.A + (size_t)cur.pm * tstep; const char* cB = (const char*)g.Bt + (size_t)cur.pn * tstep;
    S.a_ready(cur);
    if constexpr (SP2) {
        PG8_STAGE(PG8_SB(0, 0), cB, voffB); PG8_STAGE(PG8_SB(0, 1), cB + hstep, voffB); PG8_STAGE(PG8_SA(0, 0), cA, voffA); PG8_STAGE(PG8_SA(0, 1), cA + hstep, voffA);
        if (wr == 1) PG8_BAR;
        PG8_WAIT_V(2); PG8_BAR;
        PG8_STAGE(PG8_SB(1, 0), cB + kstep, voffB); PG8_STAGE(PG8_SA(1, 0), cA + kstep, voffA); PG8_STAGE(PG8_SB(1, 1), cB + hstep + kstep, voffB);
        PG8_WAIT_V(6); PG8_BAR;
    } else {
        PG8_STAGE(PG8_SB(0, 0), cB, voffB); PG8_STAGE(PG8_SA(0, 0), cA, voffA); PG8_STAGE(PG8_SB(0, 1), cB + hstep, voffB); PG8_STAGE(PG8_SA(0, 1), cA + hstep, voffA);
        if (wr == 1) PG8_BAR;
        PG8_WAIT_V(4); PG8_BAR;
        PG8_STAGE(PG8_SB(1, 0), cB + kstep, voffB); PG8_STAGE(PG8_SA(1, 0), cA + kstep, voffA); PG8_STAGE(PG8_SB(1, 1), cB + hstep + kstep, voffB);
        PG8_WAIT_V(6); PG8_BAR;
    }
    for (;;) {
        const bool has_next = S.next(ui + 1, nxt);
        const char* nA = has_next ? (const char*)g.A + (size_t)nxt.pm * tstep : cA; const char* nB = has_next ? (const char*)g.Bt + (size_t)nxt.pn * tstep : cB;
        for (int t = 0; t < nt; t += 2) {
            const bool last = (t == nt - 2);
            const char* a1 = cA + (size_t)(t + 1) * kstep;
            const char* a2 = last ? nA : cA + (size_t)(t + 2) * kstep; const char* b2 = last ? nB : cB + (size_t)(t + 2) * kstep;
            const char* a3 = a2 + kstep; const char* b3 = b2 + kstep;
            if (last && has_next) S.a_ready(nxt);
            if constexpr (Epi::KSPLIT > 0) { if (t == Epi::KSPLIT) E.ksplit(acc, cur, wr, wc, fr, fq); }
            if constexpr (SP2) {
            PG8_LDB(B0, 0, 0); PG8_LDB(B1, 0, 1); PG8_SCHED; PG8_LDA(At, 0, 0); PG8_STAGE(PG8_SA(1, 1), a1 + hstep, voffA);
            PG8_WAIT_V(8); PG8_WAIT_L(0); PG8_BAR; PG8_MMA(0, 0, At, B0); PG8_MMA(0, 1, At, B1); PG8_BAR; PG8_SCHED;
            PG8_LDA(At, 0, 1); PG8_STAGE(PG8_SB(0, 0), b2, voffB); PG8_STAGE(PG8_SB(0, 1), b2 + hstep, voffB); PG8_STAGE(PG8_SA(0, 0), a2, voffA);
            PG8_WAIT_V(8); PG8_WAIT_L(0); PG8_BAR; PG8_MMA(1, 0, At, B0); PG8_MMA(1, 1, At, B1); PG8_BAR; PG8_SCHED;
            PG8_LDB(B0, 1, 0); PG8_LDB(B1, 1, 1); PG8_SCHED; PG8_LDA(At, 1, 0); PG8_STAGE(PG8_SA(0, 1), a2 + hstep, voffA);
            PG8_WAIT_V(8); PG8_WAIT_L(0); PG8_BAR; PG8_MMA(0, 0, At, B0); PG8_MMA(0, 1, At, B1); PG8_BAR; PG8_SCHED;
            PG8_LDA(At, 1, 1); PG8_STAGE(PG8_SB(1, 0), b3, voffB); PG8_STAGE(PG8_SB(1, 1), b3 + hstep, voffB); PG8_STAGE(PG8_SA(1, 0), a3, voffA);
            PG8_WAIT_V(8); PG8_WAIT_L(0); PG8_BAR; PG8_MMA(1, 0, At, B0); PG8_MMA(1, 1, At, B1); PG8_BAR; PG8_SCHED;
            } else {
            PG8_LDB(B0, 0, 0); PG8_SCHED; PG8_LDA(At, 0, 0); PG8_STAGE(PG8_SA(1, 1), a1 + hstep, voffA);
            PG8_WAIT_L(8); PG8_BAR; PG8_WAIT_L(0); PG8_MMA(0, 0, At, B0); PG8_BAR; PG8_SCHED;
            PG8_LDB(B1, 0, 1); PG8_STAGE(PG8_SB(0, 0), b2, voffB);
            PG8_BAR; PG8_WAIT_L(0); PG8_MMA(0, 1, At, B1); PG8_BAR;
            PG8_LDA(At, 0, 1); PG8_STAGE(PG8_SA(0, 0), a2, voffA);
            PG8_BAR; PG8_WAIT_L(0); PG8_MMA(1, 0, At, B0); PG8_BAR; PG8_SCHED;
            PG8_STAGE(PG8_SB(0, 1), b2 + hstep, voffB);
            PG8_WAIT_V(6); PG8_BAR; PG8_MMA(1, 1, At, B1); PG8_BAR;
            PG8_LDB(B0, 1, 0); PG8_SCHED; PG8_LDA(At, 1, 0); PG8_STAGE(PG8_SA(0, 1), a2 + hstep, voffA);
            PG8_WAIT_L(8); PG8_BAR; PG8_WAIT_L(0); PG8_MMA(0, 0, At, B0); PG8_BAR; PG8_SCHED;
            PG8_LDB(B1, 1, 1); PG8_STAGE(PG8_SB(1, 0), b3, voffB);
            PG8_BAR; PG8_WAIT_L(0); PG8_MMA(0, 1, At, B1); PG8_BAR;
            PG8_LDA(At, 1, 1); PG8_STAGE(PG8_SA(1, 0), a3, voffA);
            PG8_BAR; PG8_WAIT_L(0); PG8_MMA(1, 0, At, B0); PG8_BAR; PG8_SCHED;
            PG8_STAGE(PG8_SB(1, 1), b3 + hstep, voffB);
            PG8_WAIT_V(6); PG8_BAR; PG8_MMA(1, 1, At, B1); PG8_BAR;
            }
        }
        if constexpr (ALIGN_EPI) { if (wr == 0) PG8_BAR; }
        if constexpr (!Epi::AFTER_DRAIN) { E(acc, cur, wr, wc, fr, fq); S.done(cur); }
        if (!has_next) break;
#pragma unroll
        for (int a = 0; a < 2; ++a)
#pragma unroll
            for (int b = 0; b < 2; ++b)
#pragma unroll
                for (int m = 0; m < 4; ++m)
#pragma unroll
                    for (int n = 0; n < 2; ++n) acc[a][b][m][n] = (f32x4){0.f, 0.f, 0.f, 0.f};
        cur = nxt; cA = nA; cB = nB; ++ui;
        if constexpr (ALIGN_EPI) { if (wr == 1) PG8_BAR; }
    }
    PG8_WAIT_V(0);
    if constexpr (!ALIGN_EPI) { if (wr == 0) PG8_BAR; }
    PG8_BAR;
    if constexpr (Epi::AFTER_DRAIN) { E.fused(acc, cur, wr, wc, fr, fq, lds, wid, lane); S.done(cur); }
#undef PG8_SA
#undef PG8_SB
#undef PG8_STAGE
#undef PG8_LDA
#undef PG8_LDB
#undef PG8_MMA
#undef PG8_WAIT_V
#undef PG8_WAIT_L
#undef PG8_BAR
#undef PG8_SCHED
}
}
#ifndef PG8_SP2
#define PG8_SP2 true
#endif
#ifndef PG8_ALIGN
#define PG8_ALIGN true
#endif
constexpr int SEQ = 8192, DM = 2048, NMETA = 16, AW = 1024, CWID = 1024, HD = 128, NH = 8, DFF = 5632, INC = 6144;
constexpr float EPS = 1e-6f;
constexpr int NWAVES = 8;
constexpr size_t MiB = 1u << 20;
constexpr size_t WS_SS2 = 0, WS_SSA = 32 * 1024, WS_XNMETA = 64 * 1024, WS_PMETA = 128 * 1024, WS_BAR = 320 * 1024, WS_IRS1 = 384 * 1024;
constexpr size_t WS_WOUT = 1 * MiB, WS_WGU = 9 * MiB, WS_WD = 53 * MiB, WS_WIN = 75 * MiB  , WS_P = 107 * MiB  , WS_OC = 204 * MiB, WS_END = 236 * MiB;
constexpr size_t OUT_XN = 0, OUT_OA = 32 * MiB;
constexpr int LDS_BYTES = 147456;

#define LAS __attribute__((address_space(3)))
typedef unsigned short bf16;
typedef unsigned v4u __attribute__((ext_vector_type(4)));
typedef unsigned v2u __attribute__((ext_vector_type(2)));
typedef float f32x4 __attribute__((ext_vector_type(4)));
typedef float f32x16 __attribute__((ext_vector_type(16)));
typedef short bf16x8 __attribute__((ext_vector_type(8)));
#define LDS_WAIT() asm volatile("s_waitcnt lgkmcnt(0)" ::: "memory")
__device__ __forceinline__ unsigned pk2(float lo, float hi) { return pg8::cvt_pk_bf16(lo, hi); }
__device__ __forceinline__ float bflo(unsigned u) { return __uint_as_float(u << 16); }
__device__ __forceinline__ float bfhi(unsigned u) { return __uint_as_float(u & 0xffff0000u); }
template <int CTRL, int ROWMASK> __device__ __forceinline__ float dpp_f(float old, float src) {
    return __builtin_bit_cast(float, __builtin_amdgcn_update_dpp(__builtin_bit_cast(int, old), __builtin_bit_cast(int, src), CTRL, ROWMASK, 0xF, false)); }
__device__ __forceinline__ float row16_sum(float v) {
    v += dpp_f<0xB1, 0xF>(0.f, v);
    v += dpp_f<0x4E, 0xF>(0.f, v);
    v += dpp_f<0x141, 0xF>(0.f, v);
    v += dpp_f<0x140, 0xF>(0.f, v);
    return v;
}
__device__ __forceinline__ float half32_sum_hi(float v) { v = row16_sum(v); v += dpp_f<0x142, 0xA>(0.f, v); return v; }
__device__ __forceinline__ float wave_sum(float v) {
    v = row16_sum(v); v += dpp_f<0x142, 0xA>(0.f, v); v += dpp_f<0x143, 0xC>(0.f, v);
    return __builtin_bit_cast(float, __builtin_amdgcn_readlane(__builtin_bit_cast(int, v), 63));
}
__device__ __forceinline__ int crow(int r, int hi) { return (r & 3) + 8 * (r >> 2) + 4 * hi; }

__device__ __forceinline__ void p0_transpose_item(const float* __restrict__ W, int N, bf16* __restrict__ WT, int K, int k0, int n0, int drow0, LAS unsigned char* scr, int lane) {
    const int l15 = lane & 15, q = lane >> 4;
    f32x4 v[16];
    const float* src = W + (size_t)(k0 + 2 * q) * N + n0 + 4 * l15;
#pragma unroll
    for (int i = 0; i < 16; ++i) v[i] = __builtin_nontemporal_load((const f32x4*)(src + (size_t)((i & 1) + 8 * (i >> 1)) * N));
#pragma unroll
    for (int j = 0; j < 8; ++j)
#pragma unroll
        for (int c = 0; c < 4; ++c) { const int n = 4 * l15 + c;
            *(LAS unsigned*)(scr + n * 128 + ((j ^ (l15 & 7)) * 16) + 4 * q) = pk2(v[2 * j][c], v[2 * j + 1][c]); }
    LDS_WAIT(); asm volatile("" ::: "memory");
    const int kc = lane & 7;
#pragma unroll
    for (int r = 0; r < 8; ++r) { const int n = (lane >> 3) + 8 * r; const v4u o = *(const LAS v4u*)(scr + n * 128 + ((kc ^ ((n >> 2) & 7)) * 16));
        *(v4u*)(WT + (size_t)(drow0 + n) * K + k0 + 8 * kc) = o; }
    LDS_WAIT(); asm volatile("" ::: "memory");
}
__device__ __forceinline__ void rms_row_to_bf16(const float* __restrict__ xrow, const float* __restrict__ g, bf16* __restrict__ orow, float* __restrict__ inv_rstd_out, int lane) {
    const f32x4* xr = (const f32x4*)xrow + 2 * lane; const f32x4* gr = (const f32x4*)g + 2 * lane;
    f32x4 v[8]; float s = 0.f;
#pragma unroll
    for (int j = 0; j < 4; ++j) { v[2 * j] = __builtin_nontemporal_load(xr + 128 * j); v[2 * j + 1] = __builtin_nontemporal_load(xr + 128 * j + 1); }
#pragma unroll
    for (int j = 0; j < 8; ++j) s += (v[j][0] * v[j][0] + v[j][1] * v[j][1]) + (v[j][2] * v[j][2] + v[j][3] * v[j][3]);
    const float var = wave_sum(s) * (1.0f / DM) + EPS; const float rstd = 1.0f / sqrtf(var);
    if (inv_rstd_out && lane == 0) *inv_rstd_out = sqrtf(var);
    v4u* o16 = (v4u*)orow + lane;
#pragma unroll
    for (int j = 0; j < 4; ++j) { const f32x4 ga = gr[128 * j], gb = gr[128 * j + 1]; const f32x4 a = v[2 * j], b = v[2 * j + 1]; v4u w;
        w.x = pk2(a[0] * rstd * ga[0], a[1] * rstd * ga[1]); w.y = pk2(a[2] * rstd * ga[2], a[3] * rstd * ga[3]);
        w.z = pk2(b[0] * rstd * gb[0], b[1] * rstd * gb[1]); w.w = pk2(b[2] * rstd * gb[2], b[3] * rstd * gb[3]); o16[64 * j] = w; }
}

struct Args { const float* in[14]; float* out; unsigned char* ws; };

__device__ __forceinline__ void p0_prologue(const Args& A, LAS unsigned char* lds, int gw, int NGW, int wave, int lane) {
    const float* x = A.in[0]; const float* meta = A.in[1]; const float* g_mix = A.in[2]; const float* w_in = A.in[3];
    const float* w_out = A.in[9]; const float* w_gate = A.in[11]; const float* w_up = A.in[12]; const float* w_down = A.in[13];
    unsigned char* ws = A.ws;
    bf16* WinT = (bf16*)(ws + WS_WIN); bf16* WoutT = (bf16*)(ws + WS_WOUT); bf16* WguT = (bf16*)(ws + WS_WGU); bf16* WdT = (bf16*)(ws + WS_WD);
    bf16* XN = (bf16*)((unsigned char*)A.out + OUT_XN); bf16* XNmeta = (bf16*)(ws + WS_XNMETA); float* ss2 = (float*)(ws + WS_SS2); float* irs1 = (float*)(ws + WS_IRS1);
    LAS unsigned char* scr = lds + wave * 8192;
    constexpr int I_IN = (DM / 64) * (INC / 64), I_OUT = (DM / 64) * (DM / 64), I_G = (DM / 64) * (DFF / 64);
    constexpr int NITEMS = I_IN + I_OUT + 2 * I_G;
    for (int it = gw; it < NITEMS; it += NGW) {
        int r = it;
        if (r < I_IN) { const int nb = INC / 64, kb = 2 * ((r >> 3) / (nb >> 2)) + (r & 1), n0 = 64 * (4 * ((r >> 3) % (nb >> 2)) + ((r >> 1) & 3));
            const int ch0 = (n0 - 4096) & 1023, drow0 = n0 < 4096 ? n0 : 4096 + (ch0 >> 7) * 256 + (n0 >= 5120 ? 128 : 0) + (ch0 & 127);
            p0_transpose_item(w_in, INC, WinT, DM, 64 * kb, n0, drow0, scr, lane); continue; } r -= I_IN;
        if (r < I_OUT) { const int nb = DM / 64, kb = 2 * ((r >> 3) / (nb >> 2)) + (r & 1), n0 = 64 * (4 * ((r >> 3) % (nb >> 2)) + ((r >> 1) & 3)); p0_transpose_item(w_out, DM, WoutT, DM, 64 * kb, n0, n0, scr, lane); continue; } r -= I_OUT;
        if (r < I_G) { const int nb = DFF / 64, kb = 2 * ((r >> 3) / (nb >> 2)) + (r & 1), n0 = 64 * (4 * ((r >> 3) % (nb >> 2)) + ((r >> 1) & 3)); p0_transpose_item(w_gate, DFF, WguT, DM, 64 * kb, n0, (n0 >> 7) * 256 + (n0 & 127), scr, lane); continue; } r -= I_G;
        { const int nb = DFF / 64, kb = 2 * ((r >> 3) / (nb >> 2)) + (r & 1), n0 = 64 * (4 * ((r >> 3) % (nb >> 2)) + ((r >> 1) & 3)); p0_transpose_item(w_up, DFF, WguT, DM, 64 * kb, n0, (n0 >> 7) * 256 + 128 + (n0 & 127), scr, lane); }
    }
    for (int m = gw; m < SEQ; m += NGW) rms_row_to_bf16(x + (size_t)m * DM, g_mix, XN + (size_t)m * DM, irs1 + m, lane);
    { const int mr = NGW - 1 - gw;
      if (mr < NMETA) rms_row_to_bf16(meta + (size_t)mr * DM, g_mix, XNmeta + (size_t)mr * DM, nullptr, lane); }
    for (int i = gw * 64 + lane; i < 2 * SEQ; i += NGW * 64) ss2[i] = 0.f;
}

__device__ __forceinline__ void wd_convert(const float* __restrict__ w_down, bf16* __restrict__ WdT, LAS unsigned char* lds, int w, int nw, int wave, int lane) {
    LAS unsigned char* scr = lds + wave * 8192;
    constexpr int I_D = (DFF / 64) * (DM / 64);
    for (int r = w; r < I_D; r += nw) { const int nb = DM / 64, kb = 2 * ((r >> 3) / (nb >> 2)) + (r & 1), n0 = 64 * (4 * ((r >> 3) % (nb >> 2)) + ((r >> 1) & 3)); p0_transpose_item(w_down, DM, WdT, DFF, 64 * kb, n0, n0, scr, lane); }
}
__device__ __forceinline__ void p1_meta(const bf16* __restrict__ XNmeta, const bf16* __restrict__ WinT, bf16* __restrict__ Pmeta, LAS unsigned char* lds, int b, int wave, int lane) {
    LAS f32x4* red = (LAS f32x4*)lds;
    const int tile = 2 * b + (wave >> 2), kq = wave & 3;
    f32x4 acc = {0.f, 0.f, 0.f, 0.f};
    {
        const bf16* arow = XNmeta + (size_t)(lane & 15) * DM + 8 * (lane >> 4) + 512 * kq;
        const bf16* brow = WinT + (size_t)(16 * tile + (lane & 15)) * DM + 8 * (lane >> 4) + 512 * kq;
#pragma unroll
        for (int s = 0; s < 16; ++s) { const bf16x8 a = *(const bf16x8*)(arow + 32 * s); const bf16x8 w = *(const bf16x8*)(brow + 32 * s);
            acc = __builtin_amdgcn_mfma_f32_16x16x32_bf16(w, a, acc, 0, 0, 0); }
    }
    red[wave * 64 + lane] = acc;
    __syncthreads();
    if (kq == 0) {
        f32x4 s = red[wave * 64 + lane] + red[(wave + 1) * 64 + lane] + red[(wave + 2) * 64 + lane] + red[(wave + 3) * 64 + lane];
        v2u w; w.x = pk2(s[0], s[1]); w.y = pk2(s[2], s[3]);
        *(v2u*)(Pmeta + (size_t)(lane & 15) * INC + 16 * tile + 4 * (lane >> 4)) = w;
    }
    __syncthreads();
}
#define XB_TMO      128
#define XB_XCNT(j)  (256  + 64 * (j))
#define XB_XSUB(j)  (1280 + 64 * (j))
#define XB_XGEN(j)  (2304 + 64 * (j))
#define XB_TOP      3328
#define XB_TOPGEN   3392
#define XCD_BAR_WORDS 3456
#define XB_SPIN_CAP (1u << 18)

__device__ __forceinline__ unsigned xb_ld(unsigned* p)              { return __hip_atomic_load(p, __ATOMIC_RELAXED, __HIP_MEMORY_SCOPE_AGENT); }
__device__ __forceinline__ unsigned xb_add(unsigned* p, unsigned v) { return __hip_atomic_fetch_add(p, v, __ATOMIC_RELAXED, __HIP_MEMORY_SCOPE_AGENT); }
__device__ __forceinline__ unsigned xb_xcc_id() { return (unsigned)__builtin_amdgcn_s_getreg((3 << 11) | 20) & 0xFu; }
#define XB_SPIN(cond, bar) do { unsigned _sp = 0; while (cond) { __builtin_amdgcn_s_sleep(1); \
    if ((++_sp & 255u) == 0u) { if (xb_ld(&(bar)[XB_TMO])) break; if (_sp > XB_SPIN_CAP) { atomicAdd(&(bar)[XB_TMO], 1u); break; } } } } while (0)

struct XcdBarrier {
    unsigned* bar; unsigned x;
    volatile LAS unsigned* st;
};

__device__ __forceinline__ XcdBarrier xcd_barrier_post(unsigned* bar, volatile LAS unsigned* st) {
    XcdBarrier b; b.bar = bar; b.x = xb_xcc_id(); b.st = st;
    if (threadIdx.x == 0) (void)xb_add(&bar[XB_XCNT(b.x)], 1u);
    return b;
}
__device__ __forceinline__ void xcd_barrier_complete(unsigned* bar, unsigned x, unsigned& nloc, unsigned& nx) {
    const unsigned G = gridDim.x * gridDim.y * gridDim.z;
    unsigned sum, cnt, mine, sp = 0u;
    for (;;) {
        sum = 0u; cnt = 0u; mine = 0u;
#pragma unroll
        for (unsigned j = 0; j < 16; ++j) { const unsigned c = xb_ld(&bar[XB_XCNT(j)]); sum += c; cnt += (c > 0u) ? 1u : 0u; mine = (j == x) ? c : mine; }
        if (sum == G) break;
        __builtin_amdgcn_s_sleep(1);
        if ((++sp & 255u) == 0u) { if (xb_ld(&bar[XB_TMO])) break; if (sp > XB_SPIN_CAP) { atomicAdd(&bar[XB_TMO], 1u); break; } }
    }
    nloc = mine > 0u ? mine : 1u; nx = cnt > 0u ? cnt : 1u;
}

__device__ __forceinline__ void xcd_barrier(const XcdBarrier& b) {
    asm volatile("s_waitcnt vmcnt(0)" ::: "memory");
    __syncthreads();
    if (threadIdx.x == 0) {
        unsigned* bar = b.bar;
        __builtin_amdgcn_s_waitcnt(0);
        unsigned nloc = b.st[0], nx = b.st[1];
        if (nloc == 0u) { xcd_barrier_complete(bar, b.x, nloc, nx); b.st[0] = nloc; b.st[1] = nx; }
        const unsigned old = xb_add(&bar[XB_XSUB(b.x)], 1u);
        const unsigned gen = old / nloc;
        if (old + 1u == (gen + 1u) * nloc) {
            __builtin_amdgcn_fence(__ATOMIC_RELEASE, "agent");
            asm volatile("s_waitcnt vmcnt(0)" ::: "memory");
            const unsigned og = xb_add(&bar[XB_TOP], 1u);
            const unsigned tg = og / nx;
            if (og + 1u == (tg + 1u) * nx) xb_add(&bar[XB_TOPGEN], 1u);
            else XB_SPIN(xb_ld(&bar[XB_TOPGEN]) == tg, bar);
            __builtin_amdgcn_fence(__ATOMIC_ACQUIRE, "agent");
            xb_add(&bar[XB_XGEN(b.x)], 1u);
            asm volatile("s_waitcnt vmcnt(0)" ::: "memory");
        } else {
            XB_SPIN(xb_ld(&bar[XB_XGEN(b.x)]) == gen, bar);
            __builtin_amdgcn_fence(__ATOMIC_ACQUIRE, "agent");
            asm volatile("s_waitcnt vmcnt(0)" ::: "memory");
        }
    }
    __syncthreads();
}
#ifndef ATT_EARLY_EXIT
#define ATT_EARLY_EXIT 1
#endif
constexpr int KROW = 272, VROW = 144;
constexpr int KBUF = 64 * KROW, VBUF = 128 * VROW;
constexpr int AT_K = 0, AT_V = 2 * KBUF, AT_FLAG = 2 * KBUF + 2 * VBUF;
constexpr float LOG2E = 1.4426950408889634f;
constexpr float EXIT_THR = 7.5231638e-37f;
constexpr int LTOT = SEQ + NMETA;

__device__ __forceinline__ const bf16* tok_row(const bf16* P, const bf16* Pmeta, int pos) { return pos < NMETA ? Pmeta + (size_t)pos * INC : P + (size_t)(pos - NMETA) * INC; }
__device__ __forceinline__ bf16x8 pack8(float a0, float a1, float a2, float a3, float a4, float a5, float a6, float a7) {
    v4u w; w.x = pk2(a0, a1); w.y = pk2(a2, a3); w.z = pk2(a4, a5); w.w = pk2(a6, a7); return __builtin_bit_cast(bf16x8, w); }

__device__ __forceinline__ void conv_meta_prep(bf16* __restrict__ P, const bf16* __restrict__ Pmeta, int lane) {
#pragma unroll
    for (int pos = NMETA - 2; pos < NMETA; ++pos)
#pragma unroll
        for (int j = 0; j < 2; ++j) { const int ch = 512 * j + 8 * lane; const bf16* r = Pmeta + (size_t)pos * INC + 4096 + (ch >> 7) * 256 + (ch & 127);
            const v4u a = *(const v4u*)r, b = *(const v4u*)(r + 128); v4u w;
#pragma unroll
            for (int c = 0; c < 4; ++c) w[c] = pk2(bflo(a[c]) * bflo(b[c]), bfhi(a[c]) * bfhi(b[c]));
            *(v4u*)(P + (ptrdiff_t)(pos - NMETA) * INC + 4096 + ch) = w; }
}
__device__ __forceinline__ void conv_row(int t, const bf16* P, const float* __restrict__ g_c, const float* __restrict__ cw, bf16* __restrict__ OC, int lane) {
    float y[16]; float ss = 0.f;
    v4u rb[2], r0[2], r1[2], r2[2];
#pragma unroll
    for (int j = 0; j < 2; ++j) { const bf16* p = P + (ptrdiff_t)t * INC + 512 * j + 8 * lane;
        rb[j] = *(const v4u*)(p + 3 * AW); r0[j] = *(const v4u*)(p + 4096); r1[j] = *(const v4u*)(p - INC + 4096); r2[j] = *(const v4u*)(p - 2 * INC + 4096); }
#pragma unroll
    for (int j = 0; j < 2; ++j) { const int ch = 512 * j + 8 * lane;
        float w0[8], w1[8], w2[8];
        { const f32x4 a = *(const f32x4*)(cw + ch), b = *(const f32x4*)(cw + ch + 4); w0[0] = a[0]; w0[1] = a[1]; w0[2] = a[2]; w0[3] = a[3]; w0[4] = b[0]; w0[5] = b[1]; w0[6] = b[2]; w0[7] = b[3]; }
        { const f32x4 a = *(const f32x4*)(cw + CWID + ch), b = *(const f32x4*)(cw + CWID + ch + 4); w1[0] = a[0]; w1[1] = a[1]; w1[2] = a[2]; w1[3] = a[3]; w1[4] = b[0]; w1[5] = b[1]; w1[6] = b[2]; w1[7] = b[3]; }
        { const f32x4 a = *(const f32x4*)(cw + 2 * CWID + ch), b = *(const f32x4*)(cw + 2 * CWID + ch + 4); w2[0] = a[0]; w2[1] = a[1]; w2[2] = a[2]; w2[3] = a[3]; w2[4] = b[0]; w2[5] = b[1]; w2[6] = b[2]; w2[7] = b[3]; }
#pragma unroll
        for (int c = 0; c < 4; ++c) {
            const float lo = bflo(rb[j][c]) * (w0[2 * c] * bflo(r2[j][c]) + w1[2 * c] * bflo(r1[j][c]) + w2[2 * c] * bflo(r0[j][c]));
            const float hh = bfhi(rb[j][c]) * (w0[2 * c + 1] * bfhi(r2[j][c]) + w1[2 * c + 1] * bfhi(r1[j][c]) + w2[2 * c + 1] * bfhi(r0[j][c]));
            y[8 * j + 2 * c] = lo; y[8 * j + 2 * c + 1] = hh; ss += lo * lo + hh * hh; }
        asm volatile("" ::: "memory"); }
    const float rs = 1.0f / sqrtf(wave_sum(ss) * (1.0f / CWID) + EPS);
#pragma unroll
    for (int j = 0; j < 2; ++j) { const int ch = 512 * j + 8 * lane; const f32x4 ga = *(const f32x4*)(g_c + ch), gb = *(const f32x4*)(g_c + ch + 4);
        v4u w; w.x = pk2(y[8 * j] * rs * ga[0], y[8 * j + 1] * rs * ga[1]); w.y = pk2(y[8 * j + 2] * rs * ga[2], y[8 * j + 3] * rs * ga[3]);
        w.z = pk2(y[8 * j + 4] * rs * gb[0], y[8 * j + 5] * rs * gb[1]); w.w = pk2(y[8 * j + 6] * rs * gb[2], y[8 * j + 7] * rs * gb[3]);
        *(v4u*)(OC + (size_t)t * DM + AW + ch) = w; }
}

__device__ __forceinline__ void attn_unit(int h, int qb, const bf16* P, const bf16* __restrict__ Pmeta, const float* __restrict__ gq, const float* __restrict__ gk,
                                          const float* __restrict__ g_a, bf16* __restrict__ OC, float* __restrict__ ssa, LAS unsigned char* lds,
                                          int conv_t0, int conv_n, const float* __restrict__ g_c, const float* __restrict__ cw) {
    int tid_ = threadIdx.x; asm volatile("" : "+v"(tid_));
    const int tid = tid_, lane = tid & 63, r32 = lane & 31, hi = lane >> 5;
    const int wid = __builtin_amdgcn_readfirstlane(tid >> 6);
    const int tq = 256 * qb + 32 * wid + r32, qpos = NMETA + tq;
    const int kchunk = tid & 15, kkey0 = tid >> 4;
    float gkv[8];
    { const f32x4 a = *(const f32x4*)(gk + 8 * kchunk), b = *(const f32x4*)(gk + 8 * kchunk + 4); gkv[0] = a[0]; gkv[1] = a[1]; gkv[2] = a[2]; gkv[3] = a[3]; gkv[4] = b[0]; gkv[5] = b[1]; gkv[6] = b[2]; gkv[7] = b[3]; }
    const int vcol = 16 * (lane >> 4) + 8 * ((lane >> 2) & 1) + (lane & 3) + 4 * ((lane >> 3) & 1);
    v4u kreg[2], vreg[2];
#define AT_LOADT(k0_) do { \
        _Pragma("unroll") for (int j_ = 0; j_ < 2; ++j_) { int pos_ = (k0_) + kkey0 + 32 * j_; pos_ = pos_ < 0 ? 0 : pos_; \
            kreg[j_] = *(const v4u*)(tok_row(P, Pmeta, pos_) + AW + h * HD + 8 * kchunk); } \
        { int pos_ = (k0_) + lane; pos_ = pos_ < 0 ? 0 : pos_; const bf16* r_ = tok_row(P, Pmeta, pos_) + 2 * AW + h * HD + 16 * wid; \
            vreg[0] = *(const v4u*)r_; vreg[1] = *(const v4u*)(r_ + 8); } } while (0)
#define AT_STORET(buf_) do { \
        _Pragma("unroll") for (int j_ = 0; j_ < 2; ++j_) { float f_[8]; float s_ = 0.f; \
            _Pragma("unroll") for (int c_ = 0; c_ < 4; ++c_) { f_[2 * c_] = bflo(kreg[j_][c_]); f_[2 * c_ + 1] = bfhi(kreg[j_][c_]); s_ += f_[2 * c_] * f_[2 * c_] + f_[2 * c_ + 1] * f_[2 * c_ + 1]; } \
            s_ = row16_sum(s_); \
            const float rs_ = 1.0f / sqrtf(s_ * (1.0f / HD) + EPS); \
            v4u w_; w_.x = pk2(f_[0] * rs_ * gkv[0], f_[1] * rs_ * gkv[1]); w_.y = pk2(f_[2] * rs_ * gkv[2], f_[3] * rs_ * gkv[3]); \
            w_.z = pk2(f_[4] * rs_ * gkv[4], f_[5] * rs_ * gkv[5]); w_.w = pk2(f_[6] * rs_ * gkv[6], f_[7] * rs_ * gkv[7]); \
            *(LAS v4u*)(lds + AT_K + (buf_) * KBUF + (kkey0 + 32 * j_) * KROW + kchunk * 16) = w_; } \
        _Pragma("unroll") for (int j_ = 0; j_ < 2; ++j_) \
            _Pragma("unroll") for (int i_ = 0; i_ < 8; ++i_) { const unsigned d_ = vreg[j_][i_ >> 1]; \
                *(LAS unsigned short*)(lds + AT_V + (buf_) * VBUF + (8 * (2 * wid + j_) + i_) * VROW + 2 * vcol) = (unsigned short)((i_ & 1) ? (d_ >> 16) : (d_ & 0xffffu)); } } while (0)

    f32x16 o[4];
#pragma unroll
    for (int d0 = 0; d0 < 4; ++d0)
#pragma unroll
        for (int r = 0; r < 16; ++r) o[d0][r] = 0.f;
    if (conv_t0 == 0) conv_meta_prep(const_cast<bf16*>(P), Pmeta, lane);
    float carry = 1.f; int wdone = 0; int crem = conv_n;
    const int Q0 = NMETA + 256 * qb, KTOP = Q0 + 256, NT = (KTOP + 63) / 64, Qw = Q0 + 32 * wid;
    LAS int* flags = (LAS int*)(lds + AT_FLAG);
    AT_LOADT(KTOP - 64);
    bf16x8 qf[8];
    {
        const bf16* qrow = P + (size_t)tq * INC + h * HD + 8 * hi;
        v4u raw[8]; float ss = 0.f;
#pragma unroll
        for (int d0 = 0; d0 < 8; ++d0) raw[d0] = *(const v4u*)(qrow + 16 * d0);
#pragma unroll
        for (int d0 = 0; d0 < 8; ++d0)
#pragma unroll
            for (int c = 0; c < 4; ++c) { const float a = bflo(raw[d0][c]), b = bfhi(raw[d0][c]); ss += a * a + b * b; }
        ss += __shfl_xor(ss, 32);
        const float sc = (1.0f / sqrtf(ss * (1.0f / HD) + EPS)) * (LOG2E * 0.08838834764831845f);
#pragma unroll
        for (int d0 = 0; d0 < 8; ++d0) { const f32x4 g0 = *(const f32x4*)(gq + 16 * d0 + 8 * hi), g1 = *(const f32x4*)(gq + 16 * d0 + 8 * hi + 4);
            qf[d0] = pack8(bflo(raw[d0][0]) * sc * g0[0], bfhi(raw[d0][0]) * sc * g0[1], bflo(raw[d0][1]) * sc * g0[2], bfhi(raw[d0][1]) * sc * g0[3],
                           bflo(raw[d0][2]) * sc * g1[0], bfhi(raw[d0][2]) * sc * g1[1], bflo(raw[d0][3]) * sc * g1[2], bfhi(raw[d0][3]) * sc * g1[3]); }
    }
    AT_STORET(0);
    __syncthreads();
    for (int it = 0; it < NT; ++it) {
        const int k0 = KTOP - 64 * (it + 1), buf = it & 1; const bool more = it + 1 < NT;
        if (more) AT_LOADT(k0 - 64);
        if (!wdone && k0 < Qw + 31) {
            const LAS unsigned char* kb = lds + AT_K + buf * KBUF + r32 * KROW + hi * 16;
            const bool needmask = (k0 + 63 >= Qw) || (k0 < 0);
            float run = carry;
            bf16x8 pa[4];
#pragma unroll
            for (int blk = 1; blk >= 0; --blk) {
                f32x16 p;
#pragma unroll
                for (int r = 0; r < 16; ++r) p[r] = 0.f;
#pragma unroll
                for (int d0 = 0; d0 < 8; ++d0) { const bf16x8 ka = *(const LAS bf16x8*)(kb + blk * 32 * KROW + d0 * 32); p = __builtin_amdgcn_mfma_f32_32x32x16_bf16(ka, qf[d0], p, 0, 0, 0); }
                if (needmask) {
#pragma unroll
                    for (int r = 0; r < 16; ++r) { const int key = k0 + 32 * blk + crow(r, hi); if (key >= qpos || key < 0) p[r] = -1e30f; }
                }
                float kp[16];
#pragma unroll
                for (int r = 0; r < 16; ++r) { const float e = __builtin_amdgcn_exp2f(__builtin_fminf(p[r], 120.f)); const float sv = __builtin_amdgcn_rcpf(1.0f + e); kp[r] = sv; p[r] = e * sv; }
                float gs[4], pg[4];
#pragma unroll
                for (int g = 0; g < 4; ++g) { const float gp = (kp[4 * g] * kp[4 * g + 1]) * (kp[4 * g + 2] * kp[4 * g + 3]);
                    const auto rr = __builtin_amdgcn_permlane32_swap(__float_as_uint(gp), __float_as_uint(gp), false, false);
                    pg[g] = __uint_as_float(rr[1]); gs[g] = __uint_as_float(rr[0]) * __uint_as_float(rr[1]); }
#pragma unroll
                for (int g = 3; g >= 0; --g) { float c = hi ? run : run * pg[g];
#pragma unroll
                    for (int i = 3; i >= 0; --i) { const int r = 4 * g + i; const float wv = p[r] * c; c *= kp[r]; p[r] = wv; }
                    run *= gs[g]; }
                pa[2 * blk] = pack8(p[0], p[1], p[2], p[3], p[4], p[5], p[6], p[7]); pa[2 * blk + 1] = pack8(p[8], p[9], p[10], p[11], p[12], p[13], p[14], p[15]);
            }
            carry = run;
            const LAS unsigned char* vb = lds + AT_V + buf * VBUF + r32 * VROW + hi * 16;
#pragma unroll
            for (int d0 = 0; d0 < 4; ++d0)
#pragma unroll
                for (int ks = 0; ks < 4; ++ks) { const bf16x8 vf = *(const LAS bf16x8*)(vb + d0 * 32 * VROW + ks * 32); o[d0] = __builtin_amdgcn_mfma_f32_32x32x16_bf16(pa[ks], vf, o[d0], 0, 0, 0); }
#if ATT_EARLY_EXIT
            wdone = __all(carry < EXIT_THR) ? 1 : 0;
#endif
        } else if (crem > 0) { conv_row(conv_t0 + conv_n - crem, P, g_c, cw, OC, lane); --crem; }
        if (lane == 0) flags[buf * 8 + wid] = wdone;
        if (more) AT_STORET(buf ^ 1);
        __syncthreads();
        int all = 1;
#pragma unroll
        for (int w = 0; w < 8; ++w) all &= flags[buf * 8 + w];
        if (all) break;
    }
    for (; crem > 0; --crem) conv_row(conv_t0 + conv_n - crem, P, g_c, cw, OC, lane);
    const int tok0 = 256 * qb + 32 * wid;
    LAS unsigned char* stg = lds + wid * 8704;
    float ga[4];
#pragma unroll
    for (int d0 = 0; d0 < 4; ++d0) ga[d0] = g_a[h * HD + 32 * d0 + r32];
#pragma unroll
    for (int r = 0; r < 16; ++r) {
        float s = (o[0][r] * o[0][r] + o[1][r] * o[1][r]) + (o[2][r] * o[2][r] + o[3][r] * o[3][r]);
        s = half32_sum_hi(s);
        if (r32 == 16) atomicAdd(ssa + tok0 + crow(r, hi), s);
#pragma unroll
        for (int d0 = 0; d0 < 4; ++d0) *(LAS unsigned short*)(stg + crow(r, hi) * 272 + (32 * d0 + r32) * 2) = (unsigned short)(pk2(o[d0][r] * ga[d0], 0.f) & 0xffffu);
    }
#pragma unroll
    for (int i = 0; i < 8; ++i) { const int chunk = i * 64 + lane, row = chunk >> 4, c16 = chunk & 15;
        const v4u v = *(const LAS v4u*)(stg + row * 272 + c16 * 16);
        *(v4u*)(OC + (size_t)(tok0 + row) * DM + h * HD + c16 * 8) = v; }
    __syncthreads();
#undef AT_LOADT
#undef AT_STORET
}

__global__ void __launch_bounds__(NWAVES * 64, 2) hymba_fwd(Args A) {
    extern __shared__ __attribute__((aligned(16))) unsigned char lds_raw[];
    LAS unsigned char* lds = (LAS unsigned char*)lds_raw;
    cg::grid_group grid = cg::this_grid();
    const int tid = threadIdx.x, lane = tid & 63, wave = __builtin_amdgcn_readfirstlane(tid >> 6);
    const int G = gridDim.x, gw = blockIdx.x * NWAVES + wave, NGW = G * NWAVES;
    unsigned char* ws = A.ws;
    bf16* WinT = (bf16*)(ws + WS_WIN); bf16* WoutT = (bf16*)(ws + WS_WOUT); bf16* WguT = (bf16*)(ws + WS_WGU); bf16* WdT = (bf16*)(ws + WS_WD);
    bf16* XN = (bf16*)((unsigned char*)A.out + OUT_XN); bf16* XNmeta = (bf16*)(ws + WS_XNMETA); bf16* Pmeta = (bf16*)(ws + WS_PMETA); float* ss2 = (float*)(ws + WS_SS2); float* ssa = (float*)(ws + WS_SSA);
    bf16* P = (bf16*)(ws + WS_P) + 2 * INC; bf16* HFF = (bf16*)(ws + WS_P); bf16* OC = (bf16*)(ws + WS_OC); bf16* A2 = (bf16*)(ws + WS_WIN);

    unsigned* barw = (unsigned*)(ws + WS_BAR);
    volatile LAS unsigned* bst = (volatile LAS unsigned*)(lds + 131072 + 64);
    if (tid < 2) bst[tid] = 0u;
    __syncthreads();
    const XcdBarrier bar = xcd_barrier_post(barw, bst);
    if (A.ws == nullptr) grid.sync();
    p0_prologue(A, lds, gw, NGW, wave, lane);
    xcd_barrier(bar);

    {
        pg8::Gemm g{XN, WinT, SEQ, INC, DM}; pg8::StaticOrder S; S.init(SEQ, INC, G, (int)blockIdx.x);
        pg8::EpiIn E{P, INC};
        pg8::gemm_phase<pg8::EpiIn, pg8::StaticOrder, PG8_ALIGN, PG8_SP2>(lds, g, S, E);
        for (int tb = blockIdx.x; tb < 192; tb += G) p1_meta(XNmeta, WinT, Pmeta, lds, tb, wave, lane);
    }
    xcd_barrier(bar);

    for (int u = blockIdx.x; u < NH * (SEQ / 256); u += G) {
        const int c0 = wave < 2 ? 3 * wave : (wave < 6 ? 6 + 4 * (wave - 2) : 22 + 5 * (wave - 6));
        attn_unit(u & 7, (SEQ / 256 - 1) - (u >> 3), P, Pmeta, A.in[4], A.in[5], A.in[7], OC, ssa, lds, 32 * u + c0, wave < 2 ? 3 : (wave < 6 ? 4 : 5), A.in[8], A.in[6]);
    }
    xcd_barrier(bar);

    {
        pg8::Gemm g{OC, WoutT, SEQ, DM, DM}; pg8::StaticOrder S; S.init(SEQ, DM, G, (int)blockIdx.x);
        pg8::EpiRes1 E{XN, (const float*)(ws + WS_IRS1), A.in[2], A2, A.in[10], ss2, DM, ssa, 1.0f / AW, EPS};
        pg8::gemm_phase<pg8::EpiRes1, pg8::StaticOrder, PG8_ALIGN, PG8_SP2>(lds, g, S, E);
    }
    xcd_barrier(bar);

    {
        pg8::Gemm g{A2, WguT, SEQ, 2 * DFF, DM}; pg8::StaticOrder S; S.init(SEQ, 2 * DFF, G, (int)blockIdx.x);
        pg8::EpiSwiGLU E{HFF, DFF, ss2, 1.0f / DM, EPS};
        pg8::gemm_phase<pg8::EpiSwiGLU, pg8::StaticOrder, PG8_ALIGN, PG8_SP2>(lds, g, S, E);
        { const int nwg = (SEQ / 256) * (2 * DFF / 256), rem = nwg % G, first = rem ? rem : 0, nshort = G - first;
          if ((int)blockIdx.x >= first) wd_convert(A.in[13], WdT, lds, ((int)blockIdx.x - first) * NWAVES + wave, nshort * NWAVES, wave, lane); }
    }
    xcd_barrier(bar);

    {
        pg8::Gemm g{HFF, WdT, SEQ, DM, DFF}; pg8::StaticOrder S; S.init(SEQ, DM, G, (int)blockIdx.x);
        pg8::EpiRes2 E{A2, A.in[10], A.out, DM};
        pg8::gemm_phase<pg8::EpiRes2, pg8::StaticOrder, PG8_ALIGN, PG8_SP2>(lds, g, S, E);
    }
}

extern "C" void kernel_launch(void* const* d_in, const int* in_sizes, int n_in, void* d_out, int out_size, void* d_ws, size_t ws_size, hipStream_t stream) {
    static int grid = 0;
    if (grid == 0) {
        if (n_in != 14 || out_size != SEQ * DM || ws_size < WS_END) { fprintf(stderr, "kernel_launch: unexpected shapes (n_in %d out %d ws %zu)\n", n_in, out_size, ws_size); grid = -1; return; }
        int dev = 0, cus = 0, per_cu = 0;
        hipGetDevice(&dev); hipDeviceGetAttribute(&cus, hipDeviceAttributeMultiprocessorCount, dev);
        if (hipFuncSetAttribute((const void*)hymba_fwd, hipFuncAttributeMaxDynamicSharedMemorySize, LDS_BYTES) != hipSuccess) { fprintf(stderr, "kernel_launch: hipFuncSetAttribute failed\n"); grid = -1; return; }
        if (hipOccupancyMaxActiveBlocksPerMultiprocessor(&per_cu, (const void*)hymba_fwd, NWAVES * 64, LDS_BYTES) != hipSuccess || per_cu < 1) { fprintf(stderr, "kernel_launch: occupancy query says %d\n", per_cu); per_cu = 1; }
        (void)hipGetLastError();
        grid = cus;
        if (grid > 256) grid = 256;
    }
    if (grid < 0) return;
    if (hipMemsetAsync((char*)d_ws + WS_BAR, 0, XCD_BAR_WORDS * 4, stream) != hipSuccess) { fprintf(stderr, "kernel_launch: memset of barrier words failed\n"); return; }
    Args a{};
    for (int i = 0; i < 14; ++i) a.in[i] = (const float*)d_in[i];
    a.out = (float*)d_out; a.ws = (unsigned char*)d_ws;
    void* args[] = {&a};
    hipError_t e = hipLaunchCooperativeKernel((const void*)hymba_fwd, dim3(grid), dim3(NWAVES * 64), args, LDS_BYTES, stream);
    if (e != hipSuccess) fprintf(stderr, "cooperative launch failed: %s (grid %d)\n", hipGetErrorString(e), grid);
}
```
